# Optimizing an MI355X kernel written in HIP

```python
import jax, jax.numpy as jnp
from jax import lax
import numpy as np

D_MODEL = 1024
BATCH = 2
SEQ = 8192
DEPTH = 1

HEAD_DIM = 64
DSA_GROUPS = ((128, 1), (512, 4), (2048, 16))
DSA_HEADS_PER_GROUP = 4
DSA_HEADS = DSA_HEADS_PER_GROUP * len(DSA_GROUPS)
MOBA_HEADS = 8
MOBA_BLOCK = 256
MOBA_TOPK = 3
MOBA_Q_CHUNK = 64
D_FF = ((8 * D_MODEL // 3 + 127) // 128) * 128
DSA_WIDTH = DSA_HEADS * HEAD_DIM
MOBA_WIDTH = MOBA_HEADS * HEAD_DIM
DSA_OUT = DSA_HEADS_PER_GROUP * HEAD_DIM
IN_WIDTH = 3 * DSA_WIDTH + 3 * MOBA_WIDTH + 2 * D_MODEL
EPS = 1e-6
NEG = -1e30

kernel_name = "hybrid_dilated_moba_macaron"

f32 = jnp.float32


def rmsnorm(x, g):
    xf = x.astype(f32)
    y = xf * lax.rsqrt(jnp.mean(xf * xf, axis=-1, keepdims=True) + EPS)
    return (y * g.astype(f32)).astype(x.dtype)


def swiglu(x, w_gate, w_up, w_down):
    return (jax.nn.silu(x @ w_gate) * (x @ w_up)) @ w_down


def alibi_slopes(n):
    return 2.0 ** (-8.0 * jnp.arange(1, n + 1, dtype=f32) / n)


def to_heads(a, n):
    b, s, _ = a.shape
    return a.reshape(b, s, n, HEAD_DIM).transpose(0, 2, 1, 3)


def dilated_window_attention(q, k, v, slopes, window, dilation):
    b, h, s, hd = q.shape
    blk = window // dilation
    L = s // dilation
    Lp = -(-L // blk) * blk
    nb = Lp // blk

    def to_residue(a):
        a = a.reshape(b, h, L, dilation, hd).transpose(0, 1, 3, 2, 4)
        return jnp.pad(a, ((0, 0), (0, 0), (0, 0), (0, Lp - L), (0, 0)))

    qr, kr, vr = to_residue(q), to_residue(k), to_residue(v)
    qb = qr.reshape(b, h, dilation, nb, blk, hd)

    def band(a):
        ap = jnp.pad(a, ((0, 0), (0, 0), (0, 0), (blk, 0), (0, 0)))
        prev = ap[:, :, :, :Lp].reshape(b, h, dilation, nb, blk, hd)
        cur = a.reshape(b, h, dilation, nb, blk, hd)
        return jnp.concatenate([prev, cur], axis=4)

    kb, vb = band(kr), band(vr)
    scores = jnp.einsum('bhrnqd,bhrnkd->bhrnqk', qb, kb).astype(f32)
    qi = jnp.arange(blk)[:, None]
    kj = jnp.arange(2 * blk)[None, :]
    delta = qi + blk - kj
    kpos = jnp.arange(nb)[:, None, None] * blk - blk + kj[None]
    valid = (delta >= 0)[None] & (delta <= blk)[None] & (kpos >= 0)
    bias = -slopes[:, None, None] * (delta * dilation).astype(f32)[None]
    scores = jnp.where(valid[None, None, None], scores + bias[None, :, None, None], NEG)
    lse = jax.nn.logsumexp(scores, axis=-1)
    p = jnp.exp(scores - lse[..., None]).astype(v.dtype)
    out = jnp.einsum('bhrnqk,bhrnkd->bhrnqd', p, vb)
    out = out.reshape(b, h, dilation, Lp, hd)[:, :, :, :L]
    out = out.transpose(0, 1, 3, 2, 4).reshape(b, h, s, hd)
    lse = lse.reshape(b, h, dilation, Lp)[..., :L].transpose(0, 1, 3, 2).reshape(b, h, s)
    return out, lse


def moba_attention(q, k, v, slopes):
    b, h, s, hd = q.shape
    nblk = -(-s // MOBA_BLOCK)
    sp = nblk * MOBA_BLOCK
    n_sel = min(MOBA_TOPK, nblk)
    padw = ((0, 0), (0, 0), (0, sp - s), (0, 0))
    q, k, v = jnp.pad(q, padw), jnp.pad(k, padw), jnp.pad(v, padw)
    bh = b * h
    kblk = k.reshape(bh, nblk, MOBA_BLOCK, hd)
    vblk = v.reshape(bh, nblk, MOBA_BLOCK, hd)
    qf = q.reshape(bh, sp, hd)
    kmean = jnp.mean(kblk.astype(f32), axis=2)
    gate = jnp.einsum('xtd,xnd->xtn', qf.astype(f32), kmean)
    own = jnp.arange(sp) // MOBA_BLOCK
    past = jnp.arange(nblk)[None, :] < own[:, None]
    gate = jnp.where(past[None], gate, NEG)
    _, sel = lax.top_k(gate, n_sel)
    slope_x = jnp.tile(slopes, b)
    nq = sp // MOBA_Q_CHUNK
    q_chunks = qf.reshape(bh, nq, MOBA_Q_CHUNK, hd).transpose(1, 0, 2, 3)
    sel_chunks = sel.reshape(bh, nq, MOBA_Q_CHUNK, n_sel).transpose(1, 0, 2, 3)
    take = jax.vmap(lambda blocks, ix: blocks[ix])
    blk_off = jnp.arange(MOBA_BLOCK)

    def chunk(args):
        qc, ix, c = args
        t = c * MOBA_Q_CHUNK + jnp.arange(MOBA_Q_CHUNK)
        own_blk = (c * MOBA_Q_CHUNK) // MOBA_BLOCK
        k_own = lax.dynamic_index_in_dim(kblk, own_blk, axis=1, keepdims=False)
        v_own = lax.dynamic_index_in_dim(vblk, own_blk, axis=1, keepdims=False)
        d_own = t[:, None] - (own_blk * MOBA_BLOCK + blk_off)[None, :]
        s_own = jnp.einsum('xqd,xkd->xqk', qc, k_own).astype(f32)
        s_own = jnp.where(d_own[None] >= 0,
                          s_own - slope_x[:, None, None] * d_own.astype(f32)[None], NEG)
        k_sel = take(kblk, ix)
        v_sel = take(vblk, ix)
        s_sel = jnp.einsum('xqd,xqjkd->xqjk', qc, k_sel).astype(f32)
        d_sel = t[None, :, None, None] - (ix[..., None] * MOBA_BLOCK + blk_off)
        ok = (ix < own_blk)[..., None]
        s_sel = jnp.where(ok, s_sel - slope_x[:, None, None, None] * d_sel.astype(f32), NEG)
        n_k = n_sel * MOBA_BLOCK
        scores = jnp.concatenate([s_sel.reshape(bh, MOBA_Q_CHUNK, n_k), s_own], axis=-1)
        p = jax.nn.softmax(scores, axis=-1).astype(v.dtype)
        p_sel = p[..., :n_k].reshape(bh, MOBA_Q_CHUNK, n_sel, MOBA_BLOCK)
        p_own = p[..., n_k:]
        return (jnp.einsum('xqjk,xqjkd->xqd', p_sel, v_sel)
                + jnp.einsum('xqk,xkd->xqd', p_own, v_own))

    out = lax.map(chunk, (q_chunks, sel_chunks, jnp.arange(nq)))
    return out.transpose(1, 0, 2, 3).reshape(b, h, sp, hd)[:, :, :s]


def hybrid_layer(x, norm_ffn1, ffn1_gate, ffn1_up, ffn1_down, norm_mix, w_in,
                 w_up_a, w_up_b, w_out, norm_ffn2, ffn2_gate, ffn2_up, ffn2_down):
    b, s, _ = x.shape
    x = x + 0.5 * swiglu(rmsnorm(x, norm_ffn1), ffn1_gate, ffn1_up, ffn1_down)
    h = rmsnorm(x, norm_mix)
    proj = h @ w_in
    o = 0
    parts = []
    for width in (DSA_WIDTH, DSA_WIDTH, DSA_WIDTH, MOBA_WIDTH, MOBA_WIDTH, MOBA_WIDTH,
                  D_MODEL, D_MODEL):
        parts.append(proj[..., o:o + width])
        o += width
    qa, ka, va, qb, kb, vb, g_a, g_b = parts
    scale = HEAD_DIM ** -0.5
    qa, ka, va = to_heads(qa, DSA_HEADS) * scale, to_heads(ka, DSA_HEADS), to_heads(va, DSA_HEADS)
    qb, kb, vb = to_heads(qb, MOBA_HEADS) * scale, to_heads(kb, MOBA_HEADS), to_heads(vb, MOBA_HEADS)

    slopes_a = alibi_slopes(DSA_HEADS)
    outs, lses = [], []
    for gi, (window, dilation) in enumerate(DSA_GROUPS):
        hs = slice(gi * DSA_HEADS_PER_GROUP, (gi + 1) * DSA_HEADS_PER_GROUP)
        og, lg = dilated_window_attention(qa[:, hs], ka[:, hs], va[:, hs], slopes_a[hs],
                                          window, dilation)
        outs.append(og)
        lses.append(lg)
    w_grp = jax.nn.softmax(jnp.stack(lses, 0), axis=0)
    y_a = jnp.sum(w_grp[..., None] * jnp.stack(outs, 0).astype(f32), axis=0).astype(x.dtype)
    y_a = y_a.transpose(0, 2, 1, 3).reshape(b, s, DSA_OUT)

    y_b = moba_attention(qb, kb, vb, alibi_slopes(MOBA_HEADS))
    y_b = y_b.transpose(0, 2, 1, 3).reshape(b, s, MOBA_WIDTH)

    merged = jax.nn.sigmoid(g_a) * (y_a @ w_up_a) + jax.nn.sigmoid(g_b) * (y_b @ w_up_b)
    x = x + merged @ w_out
    x = x + 0.5 * swiglu(rmsnorm(x, norm_ffn2), ffn2_gate, ffn2_up, ffn2_down)
    return x


def setup_inputs(seed: int = 0) -> dict:
    key = jax.random.key(seed)
    ks = jax.random.split(key, 16)

    def dense(k, fan_in, fan_out):
        return jax.random.normal(k, (DEPTH, fan_in, fan_out), f32) * fan_in ** -0.5

    def gain(k):
        return 1.0 + 0.02 * jax.random.normal(k, (DEPTH, D_MODEL), f32)

    return {
        "x": jax.random.normal(ks[0], (BATCH, SEQ, D_MODEL), f32),
        "norm_ffn1": gain(ks[1]),
        "ffn1_gate": dense(ks[2], D_MODEL, D_FF),
        "ffn1_up": dense(ks[3], D_MODEL, D_FF),
        "ffn1_down": dense(ks[4], D_FF, D_MODEL),
        "norm_mix": gain(ks[5]),
        "w_in": dense(ks[6], D_MODEL, IN_WIDTH),
        "w_up_a": dense(ks[7], DSA_OUT, D_MODEL),
        "w_up_b": dense(ks[8], MOBA_WIDTH, D_MODEL),
        "w_out": dense(ks[9], D_MODEL, D_MODEL),
        "norm_ffn2": gain(ks[10]),
        "ffn2_gate": dense(ks[11], D_MODEL, D_FF),
        "ffn2_up": dense(ks[12], D_MODEL, D_FF),
        "ffn2_down": dense(ks[13], D_FF, D_MODEL),
        "norm_final": 1.0 + 0.02 * jax.random.normal(ks[14], (D_MODEL,), f32),
    }


def reference(x, norm_ffn1, ffn1_gate, ffn1_up, ffn1_down, norm_mix, w_in, w_up_a,
              w_up_b, w_out, norm_ffn2, ffn2_gate, ffn2_up, ffn2_down, norm_final):
    for layer in range(DEPTH):
        x = hybrid_layer(x, norm_ffn1[layer], ffn1_gate[layer], ffn1_up[layer],
                         ffn1_down[layer], norm_mix[layer], w_in[layer], w_up_a[layer],
                         w_up_b[layer], w_out[layer], norm_ffn2[layer], ffn2_gate[layer],
                         ffn2_up[layer], ffn2_down[layer])
    return rmsnorm(x, norm_final)
```

```cpp
#include <hip/hip_runtime.h>
#include <cstdio>
#include <cstdint>
#include <cmath>
namespace pg8 {
#define PG8_LAS __attribute__((address_space(3)))
typedef unsigned short bf16_t;
typedef short bf16x8 __attribute__((ext_vector_type(8)));
typedef float f32x4 __attribute__((ext_vector_type(4)));
typedef unsigned u32x4 __attribute__((ext_vector_type(4)));
constexpr int BM = 256, BK = 64, HALF = 128, HTB = HALF * BK * 2  , STAGE_BYTES = 8 * HTB, NXCD = 8, WGM = 8;

__host__ __device__ __forceinline__ int lds_byte(int r, int c) { const int st = (r >> 4) * 2 + (c >> 5), rr = r & 15, cc = c & 31, ob = rr * 64 + cc * 2; return st * 1024 + (ob ^ (((ob >> 9) & 1) << 5)); }
__host__ __device__ __forceinline__ void stage_rc(int b, int& R, int& C) { const int st = b / 1024, sb = b % 1024, swz = sb ^ (((sb >> 9) & 1) << 5); R = (st >> 1) * 16 + swz / 64; C = (st & 1) * 32 + (swz % 64) / 2; }
__host__ __device__ __forceinline__ int perm32(int rho) { const int n = rho >> 4, i = rho & 15; return 8 * (i >> 2) + 4 * n + (i & 3); }

struct Unit { int pm, pn; };
struct Gemm { const bf16_t* A; const bf16_t* Bt; int M, N, K; };

struct StaticOrder {
    int nM, nN, nwg, G, c;
    __host__ __device__ void init(int M, int N, int G_, int c_) { nM = M / BM; nN = N / BM; nwg = nM * nN; G = G_; c = c_; }
    __host__ __device__ bool next(int i, Unit& u) const {
        const long L = (long)i * G + c; if (L >= nwg) return false;
        int wgid = (int)L; { const int q = nwg / NXCD, r = nwg % NXCD, xcd = wgid % NXCD, off = wgid / NXCD; wgid = (xcd < r ? xcd * (q + 1) : r * (q + 1) + (xcd - r) * q) + off; }
        const int nig = WGM * nN, gid = wgid / nig, fm = gid * WGM, gsz = (nM - fm) < WGM ? (nM - fm) : WGM;
        u.pm = fm + ((wgid % nig) % gsz); u.pn = (wgid % nig) / gsz; return true;
    }
    __device__ __forceinline__ void a_ready(const Unit&) const {}
    __device__ __forceinline__ void done(const Unit&) const {}
};

__device__ __forceinline__ unsigned cvt_pk_bf16(float lo, float hi) { unsigned r; asm volatile("v_cvt_pk_bf16_f32 %0, %1, %2" : "=v"(r) : "v"(lo), "v"(hi)); return r; }
typedef float f32x2 __attribute__((ext_vector_type(2)));

typedef unsigned u32x2 __attribute__((ext_vector_type(2)));
__device__ __forceinline__ float row_rstd(const float* ssq, int row) { return __builtin_amdgcn_rsqf(ssq[row] * (1.0f / 1024.0f) + 1e-6f); }
__device__ __forceinline__ float bf_lo(unsigned w) { return __uint_as_float(w << 16); }
__device__ __forceinline__ float bf_hi(unsigned w) { return __uint_as_float(w & 0xffff0000u); }
__device__ __forceinline__ float sigmoid_f(float z) { return __builtin_amdgcn_rcpf(1.0f + __builtin_amdgcn_exp2f(-1.4426950408889634f * z)); }

struct EpiSwiGLU {
    static constexpr bool PERM = true, AFTER_DRAIN = false;
    bf16_t* H; int ldc; const float* ssq;
    __device__ __forceinline__ void operator()(const f32x4 (&acc)[2][2][4][2], const Unit& u, int wr, int wc, int fr, int fq) const {
        const int row0 = u.pm * BM + wr * 64 + fr, col0 = u.pn * HALF + wc * 32 + 8 * fq;
#pragma unroll
        for (int ai = 0; ai < 2; ++ai)
#pragma unroll
            for (int m = 0; m < 4; ++m) { const int row = row0 + ai * HALF + m * 16; const float r = row_rstd(ssq, row);
                float h[8];
#pragma unroll
                for (int n = 0; n < 2; ++n)
#pragma unroll
                    for (int j = 0; j < 4; ++j) { const float g = acc[ai][0][m][n][j] * r, up = acc[ai][1][m][n][j] * r; h[n * 4 + j] = g * sigmoid_f(g) * up; }
                u32x4 w; w.x = cvt_pk_bf16(h[0], h[1]); w.y = cvt_pk_bf16(h[2], h[3]); w.z = cvt_pk_bf16(h[4], h[5]); w.w = cvt_pk_bf16(h[6], h[7]);
                *(u32x4*)(H + (size_t)row * ldc + col0) = w; }
    }
};

template <bool WRITE_XB> struct EpiResid {
    static constexpr bool PERM = false, AFTER_DRAIN = false;
    const float* base; float* out; bf16_t* xb; float* ssq_out; float alpha; int ldc;
    __device__ __forceinline__ void operator()(const f32x4 (&acc)[2][2][4][2], const Unit& u, int wr, int wc, int fr, int fq) const {
        const int row0 = u.pm * BM + wr * 64 + fr, col0 = u.pn * BM + wc * 32 + 4 * fq;
#pragma unroll
        for (int ai = 0; ai < 2; ++ai)
#pragma unroll
            for (int m = 0; m < 4; ++m) { const int row = row0 + ai * HALF + m * 16; const size_t off = (size_t)row * ldc + col0; float s = 0.f;
#pragma unroll
                for (int bj = 0; bj < 2; ++bj)
#pragma unroll
                    for (int n = 0; n < 2; ++n) { const f32x4 b = *(const f32x4*)(base + off + bj * HALF + n * 16); const f32x4 v = b + acc[ai][bj][m][n] * alpha;
                        *(f32x4*)(out + off + bj * HALF + n * 16) = v; s += (v[0] * v[0] + v[1] * v[1]) + (v[2] * v[2] + v[3] * v[3]);
                        if (WRITE_XB) { u32x2 w; w.x = cvt_pk_bf16(v[0], v[1]); w.y = cvt_pk_bf16(v[2], v[3]); *(u32x2*)(xb + off + bj * HALF + n * 16) = w; } }
                s += __shfl_xor(s, 16); s += __shfl_xor(s, 32);
                if (fq == 0) __hip_atomic_fetch_add(ssq_out + row, s, __ATOMIC_RELAXED, __HIP_MEMORY_SCOPE_AGENT);
                asm volatile("" ::: "memory"); }
    }
};

struct EpiQKV {
    static constexpr bool PERM = true, AFTER_DRAIN = false;
    bf16_t* QA; bf16_t* QB; const float* ssq; float* ksum; int Mrows;
    __device__ __forceinline__ void operator()(const f32x4 (&acc)[2][2][4][2], const Unit& u, int wr, int wc, int fr, int fq) const {
        const int row0 = u.pm * BM + wr * 64 + fr; bf16_t* base; int ldc, colt;
        if (u.pn < 9) { const int reg = u.pn / 3; base = QA + (size_t)reg * Mrows * 768; ldc = 768; colt = (u.pn - reg * 3) * BM; }
        else { const int p = u.pn - 9, reg = p >> 1; base = QB + (size_t)reg * Mrows * 512; ldc = 512; colt = (p & 1) * BM; }
        const int col0 = colt + wc * 32 + 8 * fq; const bool km = (u.pn == 11) || (u.pn == 12);
        f32x4 cs[2][2];
#pragma unroll
        for (int bj = 0; bj < 2; ++bj)
#pragma unroll
            for (int n = 0; n < 2; ++n) cs[bj][n] = (f32x4){0.f, 0.f, 0.f, 0.f};
#pragma unroll
        for (int ai = 0; ai < 2; ++ai)
#pragma unroll
            for (int m = 0; m < 4; ++m) { const int row = row0 + ai * HALF + m * 16; const float r = row_rstd(ssq, row); bf16_t* rowp = base + (size_t)row * ldc + col0;
#pragma unroll
                for (int bj = 0; bj < 2; ++bj) { const f32x4 v0 = acc[ai][bj][m][0] * r, v1 = acc[ai][bj][m][1] * r; cs[bj][0] += v0; cs[bj][1] += v1;
                    u32x4 w; w.x = cvt_pk_bf16(v0[0], v0[1]); w.y = cvt_pk_bf16(v0[2], v0[3]); w.z = cvt_pk_bf16(v1[0], v1[1]); w.w = cvt_pk_bf16(v1[2], v1[3]);
                    *(u32x4*)(rowp + bj * HALF) = w; } }
        if (km) {
            const int b = u.pm >> 5, blk = u.pm & 31;
#pragma unroll
            for (int bj = 0; bj < 2; ++bj)
#pragma unroll
                for (int n = 0; n < 2; ++n)
#pragma unroll
                    for (int j = 0; j < 4; ++j) { float s = cs[bj][n][j]; s += __shfl_xor(s, 1); s += __shfl_xor(s, 2); s += __shfl_xor(s, 4); s += __shfl_xor(s, 8);
                        if (fr == 0) { const int c = (u.pn - 11) * BM + bj * HALF + wc * 32 + 8 * fq + 4 * n + j; const int head = c >> 6, d = c & 63;
                            __hip_atomic_fetch_add(ksum + ((size_t)((b * 8 + head) * 32 + blk)) * 64 + d, s, __ATOMIC_RELAXED, __HIP_MEMORY_SCOPE_AGENT); } }
        }
    }
};

struct EpiSig {
    static constexpr bool PERM = true, AFTER_DRAIN = false;
    bf16_t* O; int ldc; const float* ssq;
    __device__ __forceinline__ void operator()(const f32x4 (&acc)[2][2][4][2], const Unit& u, int wr, int wc, int fr, int fq) const {
        const int row0 = u.pm * BM + wr * 64 + fr, col0 = u.pn * BM + wc * 32 + 8 * fq;
#pragma unroll
        for (int ai = 0; ai < 2; ++ai)
#pragma unroll
            for (int m = 0; m < 4; ++m) { const int row = row0 + ai * HALF + m * 16; const float r = row_rstd(ssq, row); bf16_t* rowp = O + (size_t)row * ldc + col0;
#pragma unroll
                for (int bj = 0; bj < 2; ++bj) { f32x4 v0 = acc[ai][bj][m][0] * r, v1 = acc[ai][bj][m][1] * r;
#pragma unroll
                    for (int j = 0; j < 4; ++j) { v0[j] = sigmoid_f(v0[j]); v1[j] = sigmoid_f(v1[j]); }
                    u32x4 w; w.x = cvt_pk_bf16(v0[0], v0[1]); w.y = cvt_pk_bf16(v0[2], v0[3]); w.z = cvt_pk_bf16(v1[0], v1[1]); w.w = cvt_pk_bf16(v1[2], v1[3]);
                    *(u32x4*)(rowp + bj * HALF) = w; } }
    }
};

template <bool ADD> struct EpiGate {
    static constexpr bool PERM = true, AFTER_DRAIN = false;
    const bf16_t* SIG; bf16_t* O; int ldc;
    __device__ __forceinline__ void operator()(const f32x4 (&acc)[2][2][4][2], const Unit& u, int wr, int wc, int fr, int fq) const {
        const int row0 = u.pm * BM + wr * 64 + fr, col0 = u.pn * BM + wc * 32 + 8 * fq;
#pragma unroll
        for (int ai = 0; ai < 2; ++ai)
#pragma unroll
            for (int m = 0; m < 4; ++m) { const size_t off = (size_t)(row0 + ai * HALF + m * 16) * ldc + col0;
#pragma unroll
                for (int bj = 0; bj < 2; ++bj) { const u32x4 sg = *(const u32x4*)(SIG + off + bj * HALF); f32x4 v0 = acc[ai][bj][m][0], v1 = acc[ai][bj][m][1];
                    v0[0] *= bf_lo(sg.x); v0[1] *= bf_hi(sg.x); v0[2] *= bf_lo(sg.y); v0[3] *= bf_hi(sg.y); v1[0] *= bf_lo(sg.z); v1[1] *= bf_hi(sg.z); v1[2] *= bf_lo(sg.w); v1[3] *= bf_hi(sg.w);
                    if (ADD) { const u32x4 pv = *(const u32x4*)(O + off + bj * HALF);
                        v0[0] += bf_lo(pv.x); v0[1] += bf_hi(pv.x); v0[2] += bf_lo(pv.y); v0[3] += bf_hi(pv.y); v1[0] += bf_lo(pv.z); v1[1] += bf_hi(pv.z); v1[2] += bf_lo(pv.w); v1[3] += bf_hi(pv.w); }
                    u32x4 w; w.x = cvt_pk_bf16(v0[0], v0[1]); w.y = cvt_pk_bf16(v0[2], v0[3]); w.z = cvt_pk_bf16(v1[0], v1[1]); w.w = cvt_pk_bf16(v1[2], v1[3]);
                    *(u32x4*)(O + off + bj * HALF) = w; }
                asm volatile("" ::: "memory"); }
    }
};

template <class Epi, class Sched, bool ALIGN_EPI = false, bool SP2 = false>
__device__ __forceinline__ void gemm_phase(PG8_LAS unsigned char* lds, const Gemm g, const Sched& S, const Epi& E) {
    int tid_ = threadIdx.x; asm volatile("" : "+v"(tid_));
    const int tid = tid_, wid = __builtin_amdgcn_readfirstlane(tid >> 6), lane = tid & 63, wr = wid >> 2, wc = wid & 3, fr = lane & 15, fq = lane >> 4;
    int K = g.K; asm volatile("" : "+s"(K)); const int nt = K / BK;
    unsigned voffA[2], voffB[2];
#pragma unroll
    for (int i = 0; i < 2; ++i) { int R, C; stage_rc(tid * 16 + i * 8192, R, C); const int Rb = Epi::PERM ? ((R & ~31) + perm32(R & 31)) : R;
        voffA[i] = (unsigned)(R * K + C) * 2u; voffB[i] = (unsigned)(Rb * K + C) * 2u; }
    const size_t kstep = (size_t)(BK * 2);
    const size_t hstep = (size_t)HALF * K * 2;
    const size_t tstep = 2 * hstep;
    const unsigned ldsw = (unsigned)wid * 1024u;
    const int aoff = lds_byte(wr * 64 + fr, fq * 8), boff = lds_byte(wc * 32 + fr, fq * 8);
#define PG8_SA(b, h) (((b) * 2 + (h)) * HTB)
#define PG8_SB(b, h) ((4 + (b) * 2 + (h)) * HTB)
#define PG8_STAGE(bufoff, gbase, voff) do { _Pragma("unroll") for (int _i = 0; _i < 2; ++_i) \
        __builtin_amdgcn_global_load_lds((const unsigned*)((const char*)(gbase) + (voff)[_i]), (PG8_LAS unsigned*)(lds + (bufoff) + ldsw + _i * 8192), 16, 0, 0); } while (0)
#define PG8_LDA(dst, b, h) do { _Pragma("unroll") for (int m = 0; m < 4; ++m) _Pragma("unroll") for (int k = 0; k < 2; ++k) dst[m][k] = *(const PG8_LAS bf16x8*)(lds + PG8_SA(b, h) + aoff + m * 2048 + k * 1024); } while (0)
#define PG8_LDB(dst, b, h) do { _Pragma("unroll") for (int n = 0; n < 2; ++n) _Pragma("unroll") for (int k = 0; k < 2; ++k) dst[n][k] = *(const PG8_LAS bf16x8*)(lds + PG8_SB(b, h) + boff + n * 2048 + k * 1024); } while (0)
#define PG8_MMA(ai, bj, At, Bt) do { __builtin_amdgcn_s_setprio(1); _Pragma("unroll") for (int m = 0; m < 4; ++m) _Pragma("unroll") for (int n = 0; n < 2; ++n) _Pragma("unroll") for (int k = 0; k < 2; ++k) \
        acc[ai][bj][m][n] = __builtin_amdgcn_mfma_f32_16x16x32_bf16(Bt[n][k], At[m][k], acc[ai][bj][m][n], 0, 0, 0); __builtin_amdgcn_s_setprio(0); } while (0)
#define PG8_WAIT_V(n) asm volatile("s_waitcnt vmcnt(" #n ")" ::: "memory")
#define PG8_WAIT_L(n) asm volatile("s_waitcnt lgkmcnt(" #n ")" ::: "memory")
#define PG8_BAR __builtin_amdgcn_s_barrier()
#define PG8_SCHED __builtin_amdgcn_sched_barrier(0)
    Unit cur, nxt; int ui = 0;
    if (!S.next(0, cur)) return;
    f32x4 acc[2][2][4][2];
#pragma unroll
    for (int a = 0; a < 2; ++a)
#pragma unroll
        for (int b = 0; b < 2; ++b)
#pragma unroll
            for (int m = 0; m < 4; ++m)
#pragma unroll
                for (int n = 0; n < 2; ++n) acc[a][b][m][n] = (f32x4){0.f, 0.f, 0.f, 0.f};
    bf16x8 At[4][2], B0[2][2], B1[2][2];
    const char* cA = (const char*)g.A + (size_t)cur.pm * tstep; const char* cB = (const char*)g.Bt + (size_t)cur.pn * tstep;
    S.a_ready(cur);
    if constexpr (SP2) {
        PG8_STAGE(PG8_SB(0, 0), cB, voffB); PG8_STAGE(PG8_SB(0, 1), cB + hstep, voffB); PG8_STAGE(PG8_SA(0, 0), cA, voffA); PG8_STAGE(PG8_SA(0, 1), cA + hstep, voffA);
        if (wr == 1) PG8_BAR;
        PG8_WAIT_V(2); PG8_BAR;
        PG8_STAGE(PG8_SB(1, 0), cB + kstep, voffB); PG8_STAGE(PG8_SA(1, 0), cA + kstep, voffA); PG8_STAGE(PG8_SB(1, 1), cB + hstep + kstep, voffB);
        PG8_WAIT_V(6); PG8_BAR;
    } else {
        PG8_STAGE(PG8_SB(0, 0), cB, voffB); PG8_STAGE(PG8_SA(0, 0), cA, voffA); PG8_STAGE(PG8_SB(0, 1), cB + hstep, voffB); PG8_STAGE(PG8_SA(0, 1), cA + hstep, voffA);
        if (wr == 1) PG8_BAR;
        PG8_WAIT_V(4); PG8_BAR;
        PG8_STAGE(PG8_SB(1, 0), cB + kstep, voffB); PG8_STAGE(PG8_SA(1, 0), cA + kstep, voffA); PG8_STAGE(PG8_SB(1, 1), cB + hstep + kstep, voffB);
        PG8_WAIT_V(6); PG8_BAR;
    }
    for (;;) {
        const bool has_next = S.next(ui + 1, nxt);
        const char* nA = has_next ? (const char*)g.A + (size_t)nxt.pm * tstep : cA; const char* nB = has_next ? (const char*)g.Bt + (size_t)nxt.pn * tstep : cB;
        for (int t = 0; t < nt; t += 2) {
            const bool last = (t == nt - 2);
            const char* a1 = cA + (size_t)(t + 1) * kstep;
            const char* a2 = last ? nA : cA + (size_t)(t + 2) * kstep; const char* b2 = last ? nB : cB + (size_t)(t + 2) * kstep;
            const char* a3 = a2 + kstep; const char* b3 = b2 + kstep;
            if (last && has_next) S.a_ready(nxt);
            if constexpr (SP2) {
            PG8_LDB(B0, 0, 0); PG8_LDB(B1, 0, 1); PG8_SCHED; PG8_LDA(At, 0, 0); PG8_STAGE(PG8_SA(1, 1), a1 + hstep, voffA);
            PG8_WAIT_V(8); PG8_WAIT_L(0); PG8_BAR; PG8_MMA(0, 0, At, B0); PG8_MMA(0, 1, At, B1); PG8_BAR; PG8_SCHED;
            PG8_LDA(At, 0, 1); PG8_STAGE(PG8_SB(0, 0), b2, voffB); PG8_STAGE(PG8_SB(0, 1), b2 + hstep, voffB); PG8_STAGE(PG8_SA(0, 0), a2, voffA);
            PG8_WAIT_V(8); PG8_WAIT_L(0); PG8_BAR; PG8_MMA(1, 0, At, B0); PG8_MMA(1, 1, At, B1); PG8_BAR; PG8_SCHED;
            PG8_LDB(B0, 1, 0); PG8_LDB(B1, 1, 1); PG8_SCHED; PG8_LDA(At, 1, 0); PG8_STAGE(PG8_SA(0, 1), a2 + hstep, voffA);
            PG8_WAIT_V(8); PG8_WAIT_L(0); PG8_BAR; PG8_MMA(0, 0, At, B0); PG8_MMA(0, 1, At, B1); PG8_BAR; PG8_SCHED;
            PG8_LDA(At, 1, 1); PG8_STAGE(PG8_SB(1, 0), b3, voffB); PG8_STAGE(PG8_SB(1, 1), b3 + hstep, voffB); PG8_STAGE(PG8_SA(1, 0), a3, voffA);
            PG8_WAIT_V(8); PG8_WAIT_L(0); PG8_BAR; PG8_MMA(1, 0, At, B0); PG8_MMA(1, 1, At, B1); PG8_BAR; PG8_SCHED;
            } else {
            PG8_LDB(B0, 0, 0); PG8_SCHED; PG8_LDA(At, 0, 0); PG8_STAGE(PG8_SA(1, 1), a1 + hstep, voffA);
            PG8_WAIT_L(8); PG8_BAR; PG8_WAIT_L(0); PG8_MMA(0, 0, At, B0); PG8_BAR; PG8_SCHED;
            PG8_LDB(B1, 0, 1); PG8_STAGE(PG8_SB(0, 0), b2, voffB);
            PG8_BAR; PG8_WAIT_L(0); PG8_MMA(0, 1, At, B1); PG8_BAR;
            PG8_LDA(At, 0, 1); PG8_STAGE(PG8_SA(0, 0), a2, voffA);
            PG8_BAR; PG8_WAIT_L(0); PG8_MMA(1, 0, At, B0); PG8_BAR; PG8_SCHED;
            PG8_STAGE(PG8_SB(0, 1), b2 + hstep, voffB);
            PG8_WAIT_V(6); PG8_BAR; PG8_MMA(1, 1, At, B1); PG8_BAR;
            PG8_LDB(B0, 1, 0); PG8_SCHED; PG8_LDA(At, 1, 0); PG8_STAGE(PG8_SA(0, 1), a2 + hstep, voffA);
            PG8_WAIT_L(8); PG8_BAR; PG8_WAIT_L(0); PG8_MMA(0, 0, At, B0); PG8_BAR; PG8_SCHED;
            PG8_LDB(B1, 1, 1); PG8_STAGE(PG8_SB(1, 0), b3, voffB);
            PG8_BAR; PG8_WAIT_L(0); PG8_MMA(0, 1, At, B1); PG8_BAR;
            PG8_LDA(At, 1, 1); PG8_STAGE(PG8_SA(1, 0), a3, voffA);
            PG8_BAR; PG8_WAIT_L(0); PG8_MMA(1, 0, At, B0); PG8_BAR; PG8_SCHED;
            PG8_STAGE(PG8_SB(1, 1), b3 + hstep, voffB);
            PG8_WAIT_V(6); PG8_BAR; PG8_MMA(1, 1, At, B1); PG8_BAR;
            }
        }
        if constexpr (ALIGN_EPI) { if (wr == 0) PG8_BAR; }
        if constexpr (!Epi::AFTER_DRAIN) { E(acc, cur, wr, wc, fr, fq); S.done(cur); }
        if (!has_next) break;
#pragma unroll
        for (int a = 0; a < 2; ++a)
#pragma unroll
            for (int b = 0; b < 2; ++b)
#pragma unroll
                for (int m = 0; m < 4; ++m)
#pragma unroll
                    for (int n = 0; n < 2; ++n) acc[a][b][m][n] = (f32x4){0.f, 0.f, 0.f, 0.f};
        cur = nxt; cA = nA; cB = nB; ++ui;
        if constexpr (ALIGN_EPI) { if (wr == 1) PG8_BAR; }
    }
    PG8_WAIT_V(0);
    if constexpr (!ALIGN_EPI) { if (wr == 0) PG8_BAR; }
    PG8_BAR;
    if constexpr (Epi::AFTER_DRAIN) { E.fused(acc, cur, wr, wc, fr, fq, lds, wid, lane); S.done(cur); }
#undef PG8_SA
#undef PG8_SB
#undef PG8_STAGE
#undef PG8_LDA
#undef PG8_LDB
#undef PG8_MMA
#undef PG8_WAIT_V
#undef PG8_WAIT_L
#undef PG8_BAR
#undef PG8_SCHED
}
}
#define GAS __attribute__((address_space(1)))
#define LAS __attribute__((address_space(3)))
typedef unsigned short bf16;
typedef unsigned v4u __attribute__((ext_vector_type(4)));
typedef float f32x4 __attribute__((ext_vector_type(4)));
typedef short bf16x8 __attribute__((ext_vector_type(8)));
typedef GAS unsigned gu32;
typedef GAS unsigned long long gu64;
#define RLX_AGENT __ATOMIC_RELAXED, __HIP_MEMORY_SCOPE_AGENT
#define LDS_WAIT() asm volatile("s_waitcnt lgkmcnt(0)" ::: "memory")
#define VM_WAIT() asm volatile("s_waitcnt vmcnt(0)" ::: "memory")
__device__ __forceinline__ unsigned long long rt() { return __builtin_amdgcn_s_memrealtime(); }
__device__ __forceinline__ unsigned f2bf(float f) { unsigned u = __builtin_bit_cast(unsigned, f); return (u + 0x7fffu + ((u >> 16) & 1u)) >> 16; }
__device__ __forceinline__ unsigned pk2(float lo, float hi) { return f2bf(lo) | (f2bf(hi) << 16); }

#define XB_TMO      128
#define XB_XCNT(j)  (256  + 64 * (j))
#define XB_XSUB(j)  (1280 + 64 * (j))
#define XB_XGEN(j)  (2304 + 64 * (j))
#define XB_TOP      3328
#define XB_TOPGEN   3392
#define XCD_BAR_WORDS 3456
#define XB_SPIN_CAP (1u << 18)

__device__ __forceinline__ unsigned xb_ld(unsigned* p)              { return __hip_atomic_load(p, __ATOMIC_RELAXED, __HIP_MEMORY_SCOPE_AGENT); }
__device__ __forceinline__ unsigned xb_add(unsigned* p, unsigned v) { return __hip_atomic_fetch_add(p, v, __ATOMIC_RELAXED, __HIP_MEMORY_SCOPE_AGENT); }
__device__ __forceinline__ unsigned xb_xcc_id() { return (unsigned)__builtin_amdgcn_s_getreg((3 << 11) | 20) & 0xFu; }
#define XB_SPIN(cond, bar) do { unsigned _sp = 0; while (cond) { __builtin_amdgcn_s_sleep(1); \
    if ((++_sp & 255u) == 0u) { if (xb_ld(&(bar)[XB_TMO])) break; if (_sp > XB_SPIN_CAP) { atomicAdd(&(bar)[XB_TMO], 1u); break; } } } } while (0)

struct XcdBarrier {
    unsigned* bar; unsigned x;
    volatile LAS unsigned* st;
};

__device__ __forceinline__ XcdBarrier xcd_barrier_post(unsigned* bar, volatile LAS unsigned* st) {
    XcdBarrier b; b.bar = bar; b.x = xb_xcc_id(); b.st = st;
    if (threadIdx.x == 0) (void)xb_add(&bar[XB_XCNT(b.x)], 1u);
    return b;
}
__device__ __forceinline__ void xcd_barrier_complete(unsigned* bar, unsigned x, unsigned& nloc, unsigned& nx) {
    const unsigned G = gridDim.x * gridDim.y * gridDim.z;
    unsigned sum, cnt, mine, sp = 0u;
    for (;;) {
        sum = 0u; cnt = 0u; mine = 0u;
#pragma unroll
        for (unsigned j = 0; j < 16; ++j) { const unsigned c = xb_ld(&bar[XB_XCNT(j)]); sum += c; cnt += (c > 0u) ? 1u : 0u; mine = (j == x) ? c : mine; }
        if (sum == G) break;
        __builtin_amdgcn_s_sleep(1);
        if ((++sp & 255u) == 0u) { if (xb_ld(&bar[XB_TMO])) break; if (sp > XB_SPIN_CAP) { atomicAdd(&bar[XB_TMO], 1u); break; } }
    }
    nloc = mine > 0u ? mine : 1u; nx = cnt > 0u ? cnt : 1u;
}

__device__ __forceinline__ void xcd_barrier(const XcdBarrier& b) {
    asm volatile("s_waitcnt vmcnt(0)" ::: "memory");
    __syncthreads();
    if (threadIdx.x == 0) {
        unsigned* bar = b.bar;
        __builtin_amdgcn_s_waitcnt(0);
        unsigned nloc = b.st[0], nx = b.st[1];
        if (nloc == 0u) { xcd_barrier_complete(bar, b.x, nloc, nx); b.st[0] = nloc; b.st[1] = nx; }
        const unsigned old = xb_add(&bar[XB_XSUB(b.x)], 1u);
        const unsigned gen = old / nloc;
        if (old + 1u == (gen + 1u) * nloc) {
            __builtin_amdgcn_fence(__ATOMIC_RELEASE, "agent");
            asm volatile("s_waitcnt vmcnt(0)" ::: "memory");
            const unsigned og = xb_add(&bar[XB_TOP], 1u);
            const unsigned tg = og / nx;
            if (og + 1u == (tg + 1u) * nx) xb_add(&bar[XB_TOPGEN], 1u);
            else XB_SPIN(xb_ld(&bar[XB_TOPGEN]) == tg, bar);
            __builtin_amdgcn_fence(__ATOMIC_ACQUIRE, "agent");
            xb_add(&bar[XB_XGEN(b.x)], 1u);
            asm volatile("s_waitcnt vmcnt(0)" ::: "memory");
        } else {
            XB_SPIN(xb_ld(&bar[XB_XGEN(b.x)]) == gen, bar);
            __builtin_amdgcn_fence(__ATOMIC_ACQUIRE, "agent");
            asm volatile("s_waitcnt vmcnt(0)" ::: "memory");
        }
    }
    __syncthreads();
}

namespace att {
typedef short bf16x8 __attribute__((ext_vector_type(8)));
typedef short s16x4 __attribute__((ext_vector_type(4)));
typedef float f32x16 __attribute__((ext_vector_type(16)));
typedef unsigned u32x4 __attribute__((ext_vector_type(4)));
typedef short v4i16_t __attribute__((ext_vector_type(4)));
typedef float f32x2_t __attribute__((ext_vector_type(2)));
typedef __bf16 bf16x2_t __attribute__((ext_vector_type(2)));
typedef unsigned short bfraw;
#define ALAS __attribute__((address_space(3)))
__device__ __forceinline__ int crow(int r, int hi) { return (r & 3) + 8 * (r >> 2) + 4 * hi; }
__device__ __forceinline__ unsigned cvtpk(float lo, float hi) { f32x2_t v = {lo, hi}; bf16x2_t b = __builtin_convertvector(v, bf16x2_t); return __builtin_bit_cast(unsigned, b); }
__device__ __forceinline__ float swapmax(float v) { auto rr = __builtin_amdgcn_permlane32_swap(__float_as_uint(v), __float_as_uint(v), false, false); return fmaxf(__uint_as_float(rr[0]), __uint_as_float(rr[1])); }
__device__ __forceinline__ float swapsum(float v) { auto rr = __builtin_amdgcn_permlane32_swap(__float_as_uint(v), __float_as_uint(v), false, false); return __uint_as_float(rr[0]) + __uint_as_float(rr[1]); }
__device__ __forceinline__ s16x4 vtr(ALAS const unsigned char* p) { return __builtin_bit_cast(s16x4, __builtin_amdgcn_ds_read_tr16_b64_v4i16((ALAS v4i16_t*)p)); }
__device__ __forceinline__ int clampi(int v, int lo, int hi) { return v < lo ? lo : (v > hi ? hi : v); }

__device__ __forceinline__ float attn_tile(const bfraw* Qrow, const bfraw* Kp, const bfraw* Vp, long kstride, int kidx0, int nch, int kmax, int qpos, int dlo, int dhi, float ns2,
                                           ALAS unsigned char* vimg, ALAS bfraw* stg, ALAS float* wsf, int lane) {
    const int r32 = lane & 31, hi = lane >> 5;
    bf16x8 qr[4];
#pragma unroll
    for (int d0 = 0; d0 < 4; ++d0) qr[d0] = *(const bf16x8*)(Qrow + 16 * d0 + 8 * hi);
    f32x16 o0, o1;
#pragma unroll
    for (int r = 0; r < 16; ++r) { o0[r] = 0.f; o1[r] = 0.f; }
    float m = -INFINITY, l = 0.f;
    ALAS const unsigned char* vb = vimg + ((lane >> 4) & 1) * 32 + (lane & 3) * 8 + (4 * hi + ((lane & 15) >> 2)) * 64;
    const int vkey = lane >> 3, vc16 = lane & 7;
    ALAS unsigned char* vw = vimg + (vc16 >> 2) * 4096 + (vc16 & 3) * 16;
    for (int ch = 0; ch < nch; ++ch) {
        const int k0 = kidx0 + 64 * ch;
        if (k0 + 63 < 0) continue;
        const int ka = clampi(k0 + r32, 0, kmax - 1), kb = clampi(k0 + 32 + r32, 0, kmax - 1);
        const bfraw* kpa = Kp + (long)ka * kstride + 8 * hi; const bfraw* kpb = Kp + (long)kb * kstride + 8 * hi;
        bf16x8 kfa[4], kfb[4];
#pragma unroll
        for (int d0 = 0; d0 < 4; ++d0) { kfa[d0] = *(const bf16x8*)(kpa + 16 * d0); kfb[d0] = *(const bf16x8*)(kpb + 16 * d0); }
        u32x4 vr[8];
#pragma unroll
        for (int i = 0; i < 8; ++i) { const int kk = clampi(k0 + 8 * i + vkey, 0, kmax - 1); vr[i] = *(const u32x4*)(Vp + (long)kk * kstride + vc16 * 8); }
        f32x16 p0, p1;
#pragma unroll
        for (int r = 0; r < 16; ++r) { p0[r] = 0.f; p1[r] = 0.f; }
#pragma unroll
        for (int d0 = 0; d0 < 4; ++d0) { p0 = __builtin_amdgcn_mfma_f32_32x32x16_bf16(kfa[d0], qr[d0], p0, 0, 0, 0); p1 = __builtin_amdgcn_mfma_f32_32x32x16_bf16(kfb[d0], qr[d0], p1, 0, 0, 0); }
#pragma unroll
        for (int i = 0; i < 8; ++i) { const int key = 8 * i + vkey; *(ALAS u32x4*)(vw + (key >> 4) * 1024 + (key & 15) * 64) = vr[i]; }
        float mx = -INFINITY;
#pragma unroll
        for (int r = 0; r < 16; ++r) { const int kk = k0 + crow(r, hi); const int d = qpos - kk, d2 = d - 32;
            const bool ok0 = (d >= dlo) && (d <= dhi) && (kk >= 0), ok1 = (d2 >= dlo) && (d2 <= dhi) && (kk + 32 >= 0);
            p0[r] = ok0 ? p0[r] + ns2 * (float)d : -INFINITY; p1[r] = ok1 ? p1[r] + ns2 * (float)d2 : -INFINITY;
            mx = fmaxf(mx, fmaxf(p0[r], p1[r])); }
        mx = swapmax(mx);
        const float mn = fmaxf(m, mx), mu = (mn == -INFINITY) ? 0.f : mn;
        const float alpha = __builtin_amdgcn_exp2f(m - mu);
        m = mn;
        float ls = 0.f;
#pragma unroll
        for (int r = 0; r < 16; ++r) { p0[r] = __builtin_amdgcn_exp2f(p0[r] - mu); p1[r] = __builtin_amdgcn_exp2f(p1[r] - mu); ls += p0[r] + p1[r]; }
        l = l * alpha + ls;
        if (hi == 0) wsf[r32] = alpha;
#pragma unroll
        for (int r = 0; r < 16; ++r) { const float a = wsf[crow(r, hi)]; o0[r] *= a; o1[r] *= a; }
        u32x4 pw[4];
#pragma unroll
        for (int s = 0; s < 2; ++s) { pw[s] = (u32x4){cvtpk(p0[8 * s], p0[8 * s + 1]), cvtpk(p0[8 * s + 2], p0[8 * s + 3]), cvtpk(p0[8 * s + 4], p0[8 * s + 5]), cvtpk(p0[8 * s + 6], p0[8 * s + 7])};
            pw[2 + s] = (u32x4){cvtpk(p1[8 * s], p1[8 * s + 1]), cvtpk(p1[8 * s + 2], p1[8 * s + 3]), cvtpk(p1[8 * s + 4], p1[8 * s + 5]), cvtpk(p1[8 * s + 6], p1[8 * s + 7])}; }
#pragma unroll
        for (int s = 0; s < 4; ++s) {
            const s16x4 a0 = vtr(vb + s * 1024), a1 = vtr(vb + s * 1024 + 512), b0 = vtr(vb + 4096 + s * 1024), b1 = vtr(vb + 4096 + s * 1024 + 512);
            const bf16x8 v0 = (bf16x8){a0[0], a0[1], a0[2], a0[3], a1[0], a1[1], a1[2], a1[3]}, v1 = (bf16x8){b0[0], b0[1], b0[2], b0[3], b1[0], b1[1], b1[2], b1[3]};
            const bf16x8 pa = __builtin_bit_cast(bf16x8, pw[s]);
            o0 = __builtin_amdgcn_mfma_f32_32x32x16_bf16(pa, v0, o0, 0, 0, 0);
            o1 = __builtin_amdgcn_mfma_f32_32x32x16_bf16(pa, v1, o1, 0, 0, 0);
        }
    }
    const float lt = swapsum(l);
    const float rl = lt > 0.f ? 1.0f / lt : 0.f;
    if (hi == 0) wsf[32 + r32] = rl;
#pragma unroll
    for (int r = 0; r < 16; ++r) { const int q = crow(r, hi); const float a = wsf[32 + q];
        const unsigned w0 = cvtpk(o0[r] * a, 0.f), w1 = cvtpk(o1[r] * a, 0.f);
        stg[q * 64 + r32] = (bfraw)(w0 & 0xffffu); stg[q * 64 + 32 + r32] = (bfraw)(w1 & 0xffffu); }
    return m + __builtin_amdgcn_logf(lt);
}
}

constexpr int NWAVES = 8;
constexpr int BATCH = 2, SEQ = 8192, D = 1024, FF = 2816, M = BATCH * SEQ;
constexpr int NQKV = 3840, NIN = 5888;
constexpr float QSCALE = 0.125f * 1.4426950408889634f;

constexpr size_t MiB = 1u << 20, KiB = 1u << 10;
constexpr size_t WS_CTL = 0, CTL_ZERO_BYTES = 1 * MiB;
constexpr size_t WS_W1C = 2 * MiB;
constexpr size_t WS_W1D = 13 * MiB;
constexpr size_t WS_WIN = WS_W1D + 5 * MiB + 512 * KiB;
constexpr size_t WS_WUA = 30 * MiB;
constexpr size_t WS_WUB = WS_WUA + 512 * KiB;
constexpr size_t WS_WO = WS_WUB + 1 * MiB;
constexpr size_t WS_W2C = WS_WO + 2 * MiB;
constexpr size_t WS_W2D = WS_W2C + 11 * MiB;
constexpr size_t WS_XB = 50 * MiB;
constexpr size_t WS_BIG = 82 * MiB;
constexpr size_t WS_H = WS_BIG;
constexpr size_t WS_QA = WS_BIG;
constexpr size_t WS_QB = WS_QA + 72 * MiB;
constexpr size_t WS_YA = 202 * MiB;
constexpr size_t WS_YB = 210 * MiB;
constexpr size_t WS_SCR = 226 * MiB;
constexpr size_t SCR_STRIDE = 104 * KiB, SCR_LSE = 96 * KiB;
constexpr size_t WS_SCR3 = WS_W1C;
constexpr size_t SCR3_STRIDE = 33 * KiB, SCR3_LSE = 32 * KiB;
constexpr size_t WS_SIGA = WS_BIG, WS_SIGB = WS_BIG + 32 * MiB, WS_MG = WS_BIG + 64 * MiB;
constexpr size_t WS_END = 252 * MiB;
static_assert(WS_W2D + 5 * MiB + 512 * KiB <= WS_XB && WS_SCR + 256 * SCR_STRIDE <= WS_END && 256 * SCR3_STRIDE <= 11 * MiB && WS_MG + 32 * MiB <= WS_YA, "d_ws map");
constexpr int CW_TMO = 0, CW_CODE = 1;
constexpr int CW_BAR = 4096;
constexpr int CW_QUEUE = 8192;
constexpr size_t CB_SSQ0 = 256 * KiB, CB_SSQ1 = 320 * KiB, CB_SSQ2 = 384 * KiB, CB_SSQ3 = 448 * KiB, CB_KSUM = 512 * KiB;

constexpr int RING_OFF = 0, RING_BYTES = 131072;
constexpr int LDSCTL_OFF = RING_BYTES, MISC_OFF = LDSCTL_OFF + 320;
constexpr int LDS_BYTES = 147456;
constexpr int AL_VIMG = 0, AL_STG = 65536, AL_WSF = 98304, AL_LIST = 100352, AL_CNT = 116736, AL_TCTR = 116864, AL_ITEM = 116868, AL_KS = 117760;
static_assert(AL_KS + 8192 <= RING_BYTES, "attention LDS map");

__device__ __forceinline__ float wave_sum(float v) {
#pragma unroll
    for (int o = 1; o < 64; o <<= 1) v += __shfl_xor(v, o);
    return v;
}
__device__ __forceinline__ void tr_item(const float* W, int K, int N, bf16* WT, int out_row0, int k0, int n0, const float* gain, float cs, LAS float* scr, int lane) {
#pragma unroll 8
    for (int i = 0; i < 32; ++i) { const int kk = 2 * i + (lane >> 5); const float g = gain ? gain[k0 + kk] * cs : cs; scr[kk * 33 + (lane & 31)] = W[(size_t)(k0 + kk) * N + n0 + (lane & 31)] * g; }
    LDS_WAIT(); asm volatile("" ::: "memory");
    const int c = lane & 7;
#pragma unroll
    for (int j = 0; j < 4; ++j) { const int n = (lane >> 3) + 8 * j; const LAS float* s = scr + (8 * c) * 33 + n;
        v4u o; o.x = pk2(s[0 * 33], s[1 * 33]); o.y = pk2(s[2 * 33], s[3 * 33]); o.z = pk2(s[4 * 33], s[5 * 33]); o.w = pk2(s[6 * 33], s[7 * 33]);
        *(GAS v4u*)(WT + (size_t)(out_row0 + n) * K + k0 + 8 * c) = o; }
    LDS_WAIT(); asm volatile("" ::: "memory");
}

struct Args { const float* in[15]; float* out; unsigned char* ws; };

struct Scr { bf16* O012; float* L012; bf16* O3; float* L3; };
__device__ __forceinline__ bf16* scr_o(const Scr& s, int slot, int q) { return slot < 3 ? s.O012 + ((size_t)slot * 256 + q) * 64 : s.O3 + (size_t)q * 64; }
__device__ __forceinline__ float* scr_l(const Scr& s, int slot, int q) { return slot < 3 ? s.L012 + slot * 256 + q : s.L3 + q; }

__device__ __forceinline__ void merge_slots(const Scr& sc, unsigned mask, bf16* Y, int ldy, int tid) {
    asm volatile("" : "+v"(tid));
    const int q = tid >> 1, half = tid & 1;
    float L[4], mxl = -INFINITY;
#pragma unroll
    for (int s = 0; s < 4; ++s) { L[s] = -INFINITY; if (mask & (1u << s)) { L[s] = *scr_l(sc, s, q); mxl = fmaxf(mxl, L[s]); } }
    float acc[32];
#pragma unroll
    for (int i = 0; i < 32; ++i) acc[i] = 0.f;
    float den = 0.f;
#pragma unroll
    for (int s = 0; s < 4; ++s) if (mask & (1u << s)) {
        const float w = __builtin_amdgcn_exp2f(L[s] - mxl); den += w;
        const v4u* p = (const v4u*)(scr_o(sc, s, q) + half * 32);
#pragma unroll
        for (int i = 0; i < 4; ++i) { const v4u v = p[i];
            acc[8 * i + 0] += w * __uint_as_float(v.x << 16); acc[8 * i + 1] += w * __uint_as_float(v.x & 0xffff0000u);
            acc[8 * i + 2] += w * __uint_as_float(v.y << 16); acc[8 * i + 3] += w * __uint_as_float(v.y & 0xffff0000u);
            acc[8 * i + 4] += w * __uint_as_float(v.z << 16); acc[8 * i + 5] += w * __uint_as_float(v.z & 0xffff0000u);
            acc[8 * i + 6] += w * __uint_as_float(v.w << 16); acc[8 * i + 7] += w * __uint_as_float(v.w & 0xffff0000u); }
    }
    const float rd = 1.0f / den;
    v4u* o = (v4u*)(Y + (size_t)q * ldy + half * 32);
#pragma unroll
    for (int i = 0; i < 4; ++i) { v4u w; w.x = pk2(acc[8 * i] * rd, acc[8 * i + 1] * rd); w.y = pk2(acc[8 * i + 2] * rd, acc[8 * i + 3] * rd); w.z = pk2(acc[8 * i + 4] * rd, acc[8 * i + 5] * rd); w.w = pk2(acc[8 * i + 6] * rd, acc[8 * i + 7] * rd); o[i] = w; }
}

__device__ __forceinline__ void dsa_unit(int b, int j, int sp, const bf16* QA, const bf16* KA, const bf16* VA, bf16* YA, const Scr& sc, LAS unsigned char* lds, int tid) {
    asm volatile("" : "+v"(tid));
    const int lane = tid & 63, wave = __builtin_amdgcn_readfirstlane(tid >> 6), r32 = lane & 31, hi = lane >> 5;
    LAS unsigned char* vimg = lds + AL_VIMG + wave * 8192; LAS bf16* stg = (LAS bf16*)(lds + AL_STG + wave * 4096); LAS float* wsf = (LAS float*)(lds + AL_WSF + wave * 256);
    const int T0 = sp * 256;
    for (int T = wave; T < 32; T += NWAVES) {
        int g, dil, res, i0, nvalid;
        if (T < 8) { g = 0; dil = 1; res = 0; i0 = T0 + 32 * T; nvalid = 32; }
        else if (T < 16) { g = 1; dil = 4; res = (T - 8) >> 1; i0 = (T0 >> 2) + 32 * (T & 1); nvalid = 32; }
        else { g = 2; dil = 16; res = T - 16; i0 = T0 >> 4; nvalid = 16; }
        const int h = 4 * g + j;
        const float slope = __builtin_amdgcn_exp2f(-8.0f * (float)(h + 1) / 12.0f);
        const float ns2 = -slope * (float)dil * 1.4426950408889634f;
        const size_t base = ((size_t)b * SEQ + res) * 768 + (size_t)h * 64;
        const long kstride = (long)dil * 768;
        const int myrow = r32 & (nvalid - 1);
        const bf16* Qrow = QA + base + (size_t)(i0 + myrow) * kstride;
        const int kidx0 = i0 + nvalid - 192;
        const float lse = att::attn_tile(Qrow, KA + base, VA + base, kstride, kidx0, 3, SEQ / dil, i0 + myrow, 0, 128, ns2, vimg, stg, wsf, lane);
#pragma unroll
        for (int i = 0; i < 4; ++i) { const int row = i * 8 + (lane >> 3), chn = lane & 7;
            const v4u v = *(const LAS v4u*)(stg + row * 64 + chn * 8);
            if (row < nvalid) { const int q = (i0 + row) * dil + res - T0; *(v4u*)(scr_o(sc, g, q) + chn * 8) = v; } }
        if (hi == 0 && r32 < nvalid) { const int q = (i0 + r32) * dil + res - T0; *scr_l(sc, g, q) = lse; }
    }
    __syncthreads();
    merge_slots(sc, 7u, YA + ((size_t)b * SEQ + T0) * 256 + j * 64, 256, tid);
    __syncthreads();
}

__device__ __forceinline__ void moba_unit(int b, int h, int c, const bf16* QB, const bf16* KB, const bf16* VB, const float* ksum, bf16* YB, const Scr& sc, LAS unsigned char* lds, int tid) {
    asm volatile("" : "+v"(tid));
    const int lane = tid & 63, wave = __builtin_amdgcn_readfirstlane(tid >> 6), r32 = lane & 31, hi = lane >> 5;
    LAS unsigned char* vimg = lds + AL_VIMG + wave * 8192; LAS bf16* stg = (LAS bf16*)(lds + AL_STG + wave * 4096); LAS float* wsf = (LAS float*)(lds + AL_WSF + wave * 256);
    LAS unsigned short* LIST = (LAS unsigned short*)(lds + AL_LIST); LAS int* CNT = (LAS int*)(lds + AL_CNT); LAS int* TCTR = (LAS int*)(lds + AL_TCTR); LAS float* KS = (LAS float*)(lds + AL_KS);
    const float slope = __builtin_amdgcn_exp2f(-(float)(h + 1));
    const float ns2 = -slope * 1.4426950408889634f;
    const size_t hb = ((size_t)b * SEQ) * 512 + (size_t)h * 64;
    const int nsel = c < 3 ? c : 3;
    { const float* ks = ksum + ((size_t)(b * 8 + h) * 32) * 64; for (int i = tid; i < c * 64; i += NWAVES * 64) KS[i] = ks[i]; }
    if (tid < 32) CNT[tid] = 0;
    if (tid == 32) TCTR[0] = 0;
    __syncthreads();
    if (c > 0) {
        const int q = tid >> 1, half = tid & 1;
        float qf[32];
        { const v4u* qp = (const v4u*)(QB + hb + (size_t)(c * 256 + q) * 512 + half * 32);
#pragma unroll
          for (int i = 0; i < 4; ++i) { const v4u v = qp[i];
              qf[8 * i + 0] = __uint_as_float(v.x << 16); qf[8 * i + 1] = __uint_as_float(v.x & 0xffff0000u); qf[8 * i + 2] = __uint_as_float(v.y << 16); qf[8 * i + 3] = __uint_as_float(v.y & 0xffff0000u);
              qf[8 * i + 4] = __uint_as_float(v.z << 16); qf[8 * i + 5] = __uint_as_float(v.z & 0xffff0000u); qf[8 * i + 6] = __uint_as_float(v.w << 16); qf[8 * i + 7] = __uint_as_float(v.w & 0xffff0000u); } }
        float v1 = -INFINITY, v2 = -INFINITY, v3 = -INFINITY; int i1 = 0, i2 = 0, i3 = 0;
        for (int n = 0; n < c; ++n) {
            const LAS f32x4* kp = (const LAS f32x4*)(KS + n * 64 + half * 32);
            float dot = 0.f;
#pragma unroll
            for (int d4 = 0; d4 < 8; ++d4) { const f32x4 kv = kp[d4]; dot += qf[4 * d4] * kv[0] + qf[4 * d4 + 1] * kv[1] + qf[4 * d4 + 2] * kv[2] + qf[4 * d4 + 3] * kv[3]; }
            dot += __shfl_xor(dot, 1);
            if (dot > v1) { v3 = v2; i3 = i2; v2 = v1; i2 = i1; v1 = dot; i1 = n; }
            else if (dot > v2) { v3 = v2; i3 = i2; v2 = dot; i2 = n; }
            else if (dot > v3) { v3 = dot; i3 = n; }
        }
        if (half == 0) {
            { const int pos = atomicAdd((int*)(CNT + i1), 1); LIST[i1 * 256 + pos] = (unsigned short)(q | (0 << 8)); }
            if (nsel > 1) { const int pos = atomicAdd((int*)(CNT + i2), 1); LIST[i2 * 256 + pos] = (unsigned short)(q | (1 << 8)); }
            if (nsel > 2) { const int pos = atomicAdd((int*)(CNT + i3), 1); LIST[i3 * 256 + pos] = (unsigned short)(q | (2 << 8)); }
        }
    }
    __syncthreads();
    int endp = (lane < 32 && lane < c) ? ((CNT[lane & 31] + 31) >> 5) : 0;
#pragma unroll
    for (int off = 1; off < 32; off <<= 1) { const int t = __shfl_up(endp, off); if ((lane & 31) >= off) endp += t; }
    const int total = __shfl(endp, 31);
    {
        const bf16* Qrow = QB + hb + (size_t)(c * 256 + 32 * wave + r32) * 512;
        const int nch = (32 * wave + 32 + 63) >> 6;
        const float lse = att::attn_tile(Qrow, KB + hb + (size_t)c * 256 * 512, VB + hb + (size_t)c * 256 * 512, 512, 0, nch, 256, 32 * wave + r32, 0, 1 << 28, ns2, vimg, stg, wsf, lane);
#pragma unroll
        for (int i = 0; i < 4; ++i) { const int row = i * 8 + (lane >> 3), chn = lane & 7; const v4u v = *(const LAS v4u*)(stg + row * 64 + chn * 8); *(v4u*)(scr_o(sc, 3, 32 * wave + row) + chn * 8) = v; }
        if (hi == 0) *scr_l(sc, 3, 32 * wave + r32) = lse;
    }
    for (;;) {
        int T = 0; if (lane == 0) T = atomicAdd((int*)TCTR, 1);
        T = __shfl(T, 0);
        if (T >= total) break;
        const unsigned long long bal = __ballot(lane < 32 && endp <= T);
        const int n = __popcll(bal);
        const int prev = n ? __shfl(endp, n - 1) : 0;
        const int k = T - prev, cntn = CNT[n];
        const int idx = 32 * k + r32, e = LIST[n * 256 + (idx < cntn ? idx : cntn - 1)], q = e & 255;
        const bf16* Qrow = QB + hb + (size_t)(c * 256 + q) * 512;
        const float lse = att::attn_tile(Qrow, KB + hb + (size_t)n * 256 * 512, VB + hb + (size_t)n * 256 * 512, 512, 0, 4, 256, (c - n) * 256 + q, -(1 << 28), 1 << 28, ns2, vimg, stg, wsf, lane);
#pragma unroll
        for (int i = 0; i < 4; ++i) { const int row = i * 8 + (lane >> 3), chn = lane & 7; const v4u v = *(const LAS v4u*)(stg + row * 64 + chn * 8);
            const int id2 = 32 * k + row; if (id2 < cntn) { const int e2 = LIST[n * 256 + id2]; *(v4u*)(scr_o(sc, e2 >> 8, e2 & 255) + chn * 8) = v; } }
        if (hi == 0 && idx < cntn) *scr_l(sc, e >> 8, q) = lse;
    }
    __syncthreads();
    merge_slots(sc, ((1u << nsel) - 1u) | 8u, YB + ((size_t)b * SEQ + c * 256) * 512 + h * 64, 512, tid);
    __syncthreads();
}

#ifndef SKIP_MIXER
#define SKIP_MIXER 0
#endif
#ifndef SKIP_DSA
#define SKIP_DSA 0
#endif
#ifndef SKIP_MOBA
#define SKIP_MOBA 0
#endif
#define P_W1C ((bf16*)(ws + WS_W1C))
#define P_W1D ((bf16*)(ws + WS_W1D))
#define P_WIN ((bf16*)(ws + WS_WIN))
#define P_WUA ((bf16*)(ws + WS_WUA))
#define P_WUB ((bf16*)(ws + WS_WUB))
#define P_WO ((bf16*)(ws + WS_WO))
#define P_W2C ((bf16*)(ws + WS_W2C))
#define P_W2D ((bf16*)(ws + WS_W2D))
#define P_XB ((bf16*)(ws + WS_XB))
#define P_HB ((bf16*)(ws + WS_H))
#define P_QA ((bf16*)(ws + WS_QA))
#define P_QB ((bf16*)(ws + WS_QB))
#define P_YA ((bf16*)(ws + WS_YA))
#define P_YB ((bf16*)(ws + WS_YB))
#define P_SIGA ((bf16*)(ws + WS_SIGA))
#define P_SIGB ((bf16*)(ws + WS_SIGB))
#define P_MG ((bf16*)(ws + WS_MG))
#define P_SSQ0 ((float*)(ws + CB_SSQ0))
#define P_SSQ1 ((float*)(ws + CB_SSQ1))
#define P_SSQ2 ((float*)(ws + CB_SSQ2))
#define P_SSQ3 ((float*)(ws + CB_SSQ3))
#define P_KSUM ((float*)(ws + CB_KSUM))
__global__ void __launch_bounds__(NWAVES * 64, 2) fwd_megakernel(Args args) {
    extern __shared__ __attribute__((aligned(16))) unsigned char lds_raw[];
    LAS unsigned char* lds = (LAS unsigned char*)lds_raw;
    volatile LAS unsigned* MISC = (volatile LAS unsigned*)(lds + MISC_OFF);
    const int tid = threadIdx.x, lane = tid & 63, wave = __builtin_amdgcn_readfirstlane(tid >> 6);
    const int G = gridDim.x, bx = blockIdx.x;
    unsigned char* const ws = args.ws;
    gu32* ctl = (gu32*)(ws + WS_CTL);
    const float* x_in = args.in[0];
    float* out = args.out;
    for (int u = tid; u < (LDS_BYTES - LDSCTL_OFF) / 4; u += NWAVES * 64) ((LAS unsigned*)(lds + LDSCTL_OFF))[u] = 0u;
    __syncthreads();
    XcdBarrier bar = xcd_barrier_post((unsigned*)(ctl + CW_BAR), MISC + 8);
#define GRID_BAR() xcd_barrier(bar)

    {
        LAS float* scr = (LAS float*)(lds + RING_OFF + wave * 16384);
        const int gw = bx * NWAVES + wave, NGW = G * NWAVES;
        constexpr int I_FU = (D / 64) * (FF / 32), I_FD = (FF / 64) * (D / 32), I_IN = (D / 64) * (NIN / 32), I_UA = (256 / 64) * (D / 32), I_UB = (512 / 64) * (D / 32), I_WO = (D / 64) * (D / 32);
        constexpr int NITEMS = 6 * I_FU + I_IN + I_UA + I_UB + I_WO;
        static_assert(I_FU == I_FD, "items");
        for (int it = gw; it < NITEMS; it += NGW) {
            int r = it;
            if (r < 4 * I_FU) { const int mat = r / I_FU; r -= mat * I_FU; const int nblk = FF / 32, kb = r / nblk, nb = r % nblk, n0 = 32 * nb;
                const float* W = mat == 0 ? args.in[2] : mat == 1 ? args.in[3] : mat == 2 ? args.in[11] : args.in[12]; const float* gain = mat < 2 ? args.in[1] : args.in[10];
                const int orow = 256 * (n0 >> 7) + (n0 & 127) + ((mat & 1) ? 128 : 0);
                tr_item(W, D, FF, mat < 2 ? P_W1C : P_W2C, orow, 64 * kb, n0, gain, 1.0f, scr, lane); continue; }
            r -= 4 * I_FU;
            if (r < 2 * I_FD) { const int mat = r / I_FD; r -= mat * I_FD; const int nblk = D / 32, kb = r / nblk, nb = r % nblk;
                tr_item(mat == 0 ? args.in[4] : args.in[13], FF, D, mat == 0 ? P_W1D : P_W2D, 32 * nb, 64 * kb, 32 * nb, nullptr, 1.0f, scr, lane); continue; }
            r -= 2 * I_FD;
            if (r < I_IN) { const int nblk = NIN / 32, kb = r / nblk, nb = r % nblk, n0 = 32 * nb; const bool isq = (n0 < 768) || (n0 >= 2304 && n0 < 2816);
                tr_item(args.in[6], D, NIN, P_WIN, n0, 64 * kb, n0, args.in[5], isq ? QSCALE : 1.0f, scr, lane); continue; }
            r -= I_IN;
            if (r < I_UA) { const int nblk = D / 32, kb = r / nblk, nb = r % nblk; tr_item(args.in[7], 256, D, P_WUA, 32 * nb, 64 * kb, 32 * nb, nullptr, 1.0f, scr, lane); continue; }
            r -= I_UA;
            if (r < I_UB) { const int nblk = D / 32, kb = r / nblk, nb = r % nblk; tr_item(args.in[8], 512, D, P_WUB, 32 * nb, 64 * kb, 32 * nb, nullptr, 1.0f, scr, lane); continue; }
            r -= I_UB;
            { const int nblk = D / 32, kb = r / nblk, nb = r % nblk; tr_item(args.in[9], D, D, P_WO, 32 * nb, 64 * kb, 32 * nb, nullptr, 1.0f, scr, lane); }
        }
        for (int m = gw; m < M; m += NGW) {
            const GAS f32x4* xr = (const GAS f32x4*)(x_in + (size_t)m * D) + lane; f32x4 v[4]; float s = 0.f;
#pragma unroll
            for (int j = 0; j < 4; ++j) { v[j] = xr[64 * j]; s += (v[j].x * v[j].x + v[j].y * v[j].y) + (v[j].z * v[j].z + v[j].w * v[j].w); }
            s = wave_sum(s);
            GAS unsigned long long* o8 = (GAS unsigned long long*)(P_XB + (size_t)m * D) + lane;
#pragma unroll
            for (int j = 0; j < 4; ++j) o8[64 * j] = (unsigned long long)pk2(v[j].x, v[j].y) | ((unsigned long long)pk2(v[j].z, v[j].w) << 32);
            if (lane == 0) P_SSQ0[m] = s;
        }
    }
    GRID_BAR();

    {
        pg8::Gemm g{P_XB, P_W1C, M, 2 * FF, D}; pg8::StaticOrder S; S.init(M, 2 * FF, G, bx);
        pg8::EpiSwiGLU E{P_HB, FF, P_SSQ0};
        pg8::gemm_phase<pg8::EpiSwiGLU, pg8::StaticOrder, true, true>(lds + RING_OFF, g, S, E);
    }
    GRID_BAR();
    {
        pg8::Gemm g{P_HB, P_W1D, M, D, FF}; pg8::StaticOrder S; S.init(M, D, G, bx);
        pg8::EpiResid<true> E{x_in, out, P_XB, P_SSQ1, 0.5f, D};
        pg8::gemm_phase<pg8::EpiResid<true>, pg8::StaticOrder, true, true>(lds + RING_OFF, g, S, E);
    }
    GRID_BAR();
#if !SKIP_MIXER
    {
        pg8::Gemm g{P_XB, P_WIN, M, NQKV, D}; pg8::StaticOrder S; S.init(M, NQKV, G, bx);
        pg8::EpiQKV E{P_QA, P_QB, P_SSQ1, P_KSUM, M};
        pg8::gemm_phase<pg8::EpiQKV, pg8::StaticOrder, true, true>(lds + RING_OFF, g, S, E);
    }
    GRID_BAR();
    {
        Scr sc; sc.O012 = (bf16*)(ws + WS_SCR + (size_t)bx * SCR_STRIDE); sc.L012 = (float*)(ws + WS_SCR + (size_t)bx * SCR_STRIDE + SCR_LSE);
        sc.O3 = (bf16*)(ws + WS_SCR3 + (size_t)bx * SCR3_STRIDE); sc.L3 = (float*)(ws + WS_SCR3 + (size_t)bx * SCR3_STRIDE + SCR3_LSE);
        const bf16* KA = P_QA + (size_t)M * 768; const bf16* VA = KA + (size_t)M * 768; const bf16* KB = P_QB + (size_t)M * 512; const bf16* VB = KB + (size_t)M * 512;
        LAS int* ITEM = (LAS int*)(lds + AL_ITEM);
        int tid_a = threadIdx.x; asm volatile("" : "+v"(tid_a));
        constexpr int N_MOBA_BIG = 16 * 29, N_DSA = 256, N_ITEMS = 512 + 256;
        for (;;) {
            if (tid == 0) ITEM[0] = (int)__hip_atomic_fetch_add(ctl + CW_QUEUE, 1u, RLX_AGENT);
            __syncthreads();
            const int it = ITEM[0];
            __syncthreads();
            if (it >= N_ITEMS) break;
            int kind, pa, pb, pc;
            if (it < N_MOBA_BIG) { kind = 1; pc = 31 - it / 16; pa = (it % 16) >> 3; pb = it & 7; }
            else if (it < N_MOBA_BIG + N_DSA) { const int d = it - N_MOBA_BIG; kind = 0; pa = d >> 7; pb = (d >> 5) & 3; pc = d & 31; }
            else { const int r = it - N_MOBA_BIG - N_DSA; kind = 1; pc = 2 - r / 16; pa = (r % 16) >> 3; pb = r & 7; }
            if (kind) {
#if !SKIP_MOBA
                moba_unit(pa, pb, pc, P_QB, KB, VB, P_KSUM, P_YB, sc, lds, tid_a);
#endif
            } else {
#if !SKIP_DSA
                dsa_unit(pa, pb, pc, P_QA, KA, VA, P_YA, sc, lds, tid_a);
#endif
            }
        }
#if SKIP_DSA
        for (size_t i = (size_t)bx * 512 + tid; i < (size_t)M * 256 / 8; i += (size_t)G * 512) ((v4u*)P_YA)[i] = (v4u){0u, 0u, 0u, 0u};
#endif
#if SKIP_MOBA
        for (size_t i = (size_t)bx * 512 + tid; i < (size_t)M * 512 / 8; i += (size_t)G * 512) ((v4u*)P_YB)[i] = (v4u){0u, 0u, 0u, 0u};
#endif
    }
    GRID_BAR();
    {
        pg8::StaticOrder S; S.init(M, D, G, bx);
        { pg8::Gemm g{P_XB, P_WIN + (size_t)NQKV * D, M, D, D}; pg8::EpiSig E{P_SIGA, D, P_SSQ1}; pg8::gemm_phase<pg8::EpiSig, pg8::StaticOrder, true, true>(lds + RING_OFF, g, S, E); }
        { pg8::Gemm g{P_XB, P_WIN + (size_t)(NQKV + D) * D, M, D, D}; pg8::EpiSig E{P_SIGB, D, P_SSQ1}; pg8::gemm_phase<pg8::EpiSig, pg8::StaticOrder, true, true>(lds + RING_OFF, g, S, E); }
        { pg8::Gemm g{P_YA, P_WUA, M, D, 256}; pg8::EpiGate<false> E{P_SIGA, P_MG, D}; pg8::gemm_phase<pg8::EpiGate<false>, pg8::StaticOrder, true, true>(lds + RING_OFF, g, S, E); }
        { pg8::Gemm g{P_YB, P_WUB, M, D, 512}; pg8::EpiGate<true> E{P_SIGB, P_MG, D}; pg8::gemm_phase<pg8::EpiGate<true>, pg8::StaticOrder, true, true>(lds + RING_OFF, g, S, E); }
    }
    GRID_BAR();
    {
        pg8::Gemm g{P_MG, P_WO, M, D, D}; pg8::StaticOrder S; S.init(M, D, G, bx);
        pg8::EpiResid<true> E{out, out, P_XB, P_SSQ2, 1.0f, D};
        pg8::gemm_phase<pg8::EpiResid<true>, pg8::StaticOrder, true, true>(lds + RING_OFF, g, S, E);
    }
    GRID_BAR();
    const float* SSQ_F2 = P_SSQ2;
#else
    const float* SSQ_F2 = P_SSQ1;
#endif
    {
        pg8::Gemm g{P_XB, P_W2C, M, 2 * FF, D}; pg8::StaticOrder S; S.init(M, 2 * FF, G, bx);
        pg8::EpiSwiGLU E{P_HB, FF, SSQ_F2};
        pg8::gemm_phase<pg8::EpiSwiGLU, pg8::StaticOrder, true, true>(lds + RING_OFF, g, S, E);
    }
    GRID_BAR();
    {
        pg8::Gemm g{P_HB, P_W2D, M, D, FF}; pg8::StaticOrder S; S.init(M, D, G, bx);
        pg8::EpiResid<false> E{out, out, nullptr, P_SSQ3, 0.5f, D};
        pg8::gemm_phase<pg8::EpiResid<false>, pg8::StaticOrder, true, true>(lds + RING_OFF, g, S, E);
    }
    GRID_BAR();
    {
        const int gw = bx * NWAVES + wave, NGW = G * NWAVES; const float* gf = args.in[14];
        const unsigned bad = __hip_atomic_load(ctl + CW_BAR + XB_TMO, RLX_AGENT);
        f32x4 gv[4];
#pragma unroll
        for (int j = 0; j < 4; ++j) gv[j] = ((const GAS f32x4*)gf)[lane + 64 * j];
        for (int m = gw; m < M; m += NGW) {
            GAS f32x4* xr = (GAS f32x4*)(out + (size_t)m * D) + lane; float r = __builtin_amdgcn_rsqf(P_SSQ3[m] * (1.0f / 1024.0f) + 1e-6f);
            if (bad) r = __builtin_nanf("");
#pragma unroll
            for (int j = 0; j < 4; ++j) { const f32x4 v = xr[64 * j]; xr[64 * j] = v * r * gv[j]; }
        }
    }
}

extern "C" void kernel_launch(void* const* d_in, const int* in_sizes, int n_in, void* d_out, int out_size, void* d_ws, size_t ws_size, hipStream_t stream) {
    static int grid = 0;
    if (grid == 0) {
        if (n_in != 15 || in_sizes[0] != M * D || out_size != M * D || ws_size < WS_END) { fprintf(stderr, "kernel_launch: unexpected shapes (n_in %d, in0 %d, out %d, ws %zu)\n", n_in, n_in > 0 ? in_sizes[0] : -1, out_size, ws_size); grid = -1; return; }
        int dev = 0, cus = 0, per_cu = 0;
        if (hipGetDevice(&dev) != hipSuccess || hipDeviceGetAttribute(&cus, hipDeviceAttributeMultiprocessorCount, dev) != hipSuccess) { grid = -1; return; }
        if (hipFuncSetAttribute((const void*)fwd_megakernel, hipFuncAttributeMaxDynamicSharedMemorySize, LDS_BYTES) != hipSuccess) { fprintf(stderr, "kernel_launch: hipFuncSetAttribute failed\n"); grid = -1; return; }
        if (hipOccupancyMaxActiveBlocksPerMultiprocessor(&per_cu, (const void*)fwd_megakernel, NWAVES * 64, LDS_BYTES) != hipSuccess || per_cu < 1)
            fprintf(stderr, "kernel_launch: note: occupancy query reports %d workgroups per CU\n", per_cu);
        (void)hipGetLastError();
        grid = cus > 256 ? 256 : cus;
    }
    if (grid < 0) return;
    if (hipMemsetAsync((char*)d_ws + WS_CTL, 0, CTL_ZERO_BYTES, stream) != hipSuccess) { fprintf(stderr, "kernel_launch: memset failed\n"); return; }
    Args a{};
    for (int i = 0; i < 15; ++i) a.in[i] = (const float*)d_in[i];
    a.out = (float*)d_out; a.ws = (unsigned char*)d_ws;
    hipLaunchKernelGGL(fwd_megakernel, dim3(grid), dim3(NWAVES * 64), LDS_BYTES, stream, a);
}
```

```cpp
#include <hip/hip_runtime.h>
#include <cstdio>
#include <cstdint>
#include <cmath>
namespace pg8 {
#define PG8_LAS __attribute__((address_space(3)))
typedef unsigned short bf16_t;
typedef short bf16x8 __attribute__((ext_vector_type(8)));
typedef float f32x4 __attribute__((ext_vector_type(4)));
typedef unsigned u32x4 __attribute__((ext_vector_type(4)));
constexpr int BM = 256, BK = 64, HALF = 128, HTB = HALF * BK * 2  , STAGE_BYTES = 8 * HTB, NXCD = 8, WGM = 8;

__host__ __device__ __forceinline__ int lds_byte(int r, int c) { const int st = (r >> 4) * 2 + (c >> 5), rr = r & 15, cc = c & 31, ob = rr * 64 + cc * 2; return st * 1024 + (ob ^ (((ob >> 9) & 1) << 5)); }
__host__ __device__ __forceinline__ void stage_rc(int b, int& R, int& C) { const int st = b / 1024, sb = b % 1024, swz = sb ^ (((sb >> 9) & 1) << 5); R = (st >> 1) * 16 + swz / 64; C = (st & 1) * 32 + (swz % 64) / 2; }
__host__ __device__ __forceinline__ int perm32(int rho) { const int n = rho >> 4, i = rho & 15; return 8 * (i >> 2) + 4 * n + (i & 3); }

struct Unit { int pm, pn; };
struct Gemm { const bf16_t* A; const bf16_t* Bt; int M, N, K; };

struct StaticOrder {
    int nM, nN, nwg, G, c;
    __host__ __device__ void init(int M, int N, int G_, int c_) { nM = M / BM; nN = N / BM; nwg = nM * nN; G = G_; c = c_; }
    __host__ __device__ bool next(int i, Unit& u) const {
        const long L = (long)i * G + c; if (L >= nwg) return false;
        int wgid = (int)L; { const int q = nwg / NXCD, r = nwg % NXCD, xcd = wgid % NXCD, off = wgid / NXCD; wgid = (xcd < r ? xcd * (q + 1) : r * (q + 1) + (xcd - r) * q) + off; }
        const int nig = WGM * nN, gid = wgid / nig, fm = gid * WGM, gsz = (nM - fm) < WGM ? (nM - fm) : WGM;
        u.pm = fm + ((wgid % nig) % gsz); u.pn = (wgid % nig) / gsz; return true;
    }
    __device__ __forceinline__ void a_ready(const Unit&) const {}
    __device__ __forceinline__ void done(const Unit&) const {}
};

__device__ __forceinline__ unsigned cvt_pk_bf16(float lo, float hi) { unsigned r; asm volatile("v_cvt_pk_bf16_f32 %0, %1, %2" : "=v"(r) : "v"(lo), "v"(hi)); return r; }
typedef float f32x2 __attribute__((ext_vector_type(2)));

typedef unsigned u32x2 __attribute__((ext_vector_type(2)));
__device__ __forceinline__ float row_rstd(const float* ssq, int row) { return __builtin_amdgcn_rsqf(ssq[row] * (1.0f / 1024.0f) + 1e-6f); }
__device__ __forceinline__ float bf_lo(unsigned w) { return __uint_as_float(w << 16); }
__device__ __forceinline__ float bf_hi(unsigned w) { return __uint_as_float(w & 0xffff0000u); }
__device__ __forceinline__ float sigmoid_f(float z) { return __builtin_amdgcn_rcpf(1.0f + __builtin_amdgcn_exp2f(-1.4426950408889634f * z)); }

struct EpiSwiGLU {
    static constexpr bool PERM = true, AFTER_DRAIN = false;
    bf16_t* H; int ldc; const float* ssq;
    __device__ __forceinline__ void operator()(const f32x4 (&acc)[2][2][4][2], const Unit& u, int wr, int wc, int fr, int fq) const {
        const int row0 = u.pm * BM + wr * 64 + fr, col0 = u.pn * HALF + wc * 32 + 8 * fq;
#pragma unroll
        for (int ai = 0; ai < 2; ++ai)
#pragma unroll
            for (int m = 0; m < 4; ++m) { const int row = row0 + ai * HALF + m * 16; const float r = row_rstd(ssq, row);
                float h[8];
#pragma unroll
                for (int n = 0; n < 2; ++n)
#pragma unroll
                    for (int j = 0; j < 4; ++j) { const float g = acc[ai][0][m][n][j] * r, up = acc[ai][1][m][n][j] * r; h[n * 4 + j] = g * sigmoid_f(g) * up; }
                u32x4 w; w.x = cvt_pk_bf16(h[0], h[1]); w.y = cvt_pk_bf16(h[2], h[3]); w.z = cvt_pk_bf16(h[4], h[5]); w.w = cvt_pk_bf16(h[6], h[7]);
                *(u32x4*)(H + (size_t)row * ldc + col0) = w; }
    }
};

template <bool WRITE_XB> struct EpiResid {
    static constexpr bool PERM = false, AFTER_DRAIN = false;
    const float* base; float* out; bf16_t* xb; float* ssq_out; float alpha; int ldc;
    __device__ __forceinline__ void operator()(const f32x4 (&acc)[2][2][4][2], const Unit& u, int wr, int wc, int fr, int fq) const {
        const int row0 = u.pm * BM + wr * 64 + fr, col0 = u.pn * BM + wc * 32 + 4 * fq;
#pragma unroll
        for (int ai = 0; ai < 2; ++ai)
#pragma unroll
            for (int m = 0; m < 4; ++m) { const int row = row0 + ai * HALF + m * 16; const size_t off = (size_t)row * ldc + col0; float s = 0.f;
#pragma unroll
                for (int bj = 0; bj < 2; ++bj)
#pragma unroll
                    for (int n = 0; n < 2; ++n) { const f32x4 b = *(const f32x4*)(base + off + bj * HALF + n * 16); const f32x4 v = b + acc[ai][bj][m][n] * alpha;
                        *(f32x4*)(out + off + bj * HALF + n * 16) = v; s += (v[0] * v[0] + v[1] * v[1]) + (v[2] * v[2] + v[3] * v[3]);
                        if (WRITE_XB) { u32x2 w; w.x = cvt_pk_bf16(v[0], v[1]); w.y = cvt_pk_bf16(v[2], v[3]); *(u32x2*)(xb + off + bj * HALF + n * 16) = w; } }
                s += __shfl_xor(s, 16); s += __shfl_xor(s, 32);
                if (fq == 0) __hip_atomic_fetch_add(ssq_out + row, s, __ATOMIC_RELAXED, __HIP_MEMORY_SCOPE_AGENT);
                asm volatile("" ::: "memory"); }
    }
};

struct EpiQKV {
    static constexpr bool PERM = true, AFTER_DRAIN = false;
    bf16_t* QA; bf16_t* QB; const float* ssq; float* ksum; int Mrows;
    __device__ __forceinline__ void operator()(const f32x4 (&acc)[2][2][4][2], const Unit& u, int wr, int wc, int fr, int fq) const {
        const int row0 = u.pm * BM + wr * 64 + fr; bf16_t* base; int ldc, colt;
        if (u.pn < 9) { const int reg = u.pn / 3; base = QA + (size_t)reg * Mrows * 768; ldc = 768; colt = (u.pn - reg * 3) * BM; }
        else { const int p = u.pn - 9, reg = p >> 1; base = QB + (size_t)reg * Mrows * 512; ldc = 512; colt = (p & 1) * BM; }
        const int col0 = colt + wc * 32 + 8 * fq; const bool km = (u.pn == 11) || (u.pn == 12);
        f32x4 cs[2][2];
#pragma unroll
        for (int bj = 0; bj < 2; ++bj)
#pragma unroll
            for (int n = 0; n < 2; ++n) cs[bj][n] = (f32x4){0.f, 0.f, 0.f, 0.f};
#pragma unroll
        for (int ai = 0; ai < 2; ++ai)
#pragma unroll
            for (int m = 0; m < 4; ++m) { const int row = row0 + ai * HALF + m * 16; const float r = row_rstd(ssq, row); bf16_t* rowp = base + (size_t)row * ldc + col0;
#pragma unroll
                for (int bj = 0; bj < 2; ++bj) { const f32x4 v0 = acc[ai][bj][m][0] * r, v1 = acc[ai][bj][m][1] * r; cs[bj][0] += v0; cs[bj][1] += v1;
                    u32x4 w; w.x = cvt_pk_bf16(v0[0], v0[1]); w.y = cvt_pk_bf16(v0[2], v0[3]); w.z = cvt_pk_bf16(v1[0], v1[1]); w.w = cvt_pk_bf16(v1[2], v1[3]);
                    *(u32x4*)(rowp + bj * HALF) = w; } }
        if (km) {
            const int b = u.pm >> 5, blk = u.pm & 31;
#pragma unroll
            for (int bj = 0; bj < 2; ++bj)
#pragma unroll
                for (int n = 0; n < 2; ++n)
#pragma unroll
                    for (int j = 0; j < 4; ++j) { float s = cs[bj][n][j]; s += __shfl_xor(s, 1); s += __shfl_xor(s, 2); s += __shfl_xor(s, 4); s += __shfl_xor(s, 8);
                        if (fr == 0) { const int c = (u.pn - 11) * BM + bj * HALF + wc * 32 + 8 * fq + 4 * n + j; const int head = c >> 6, d = c & 63;
                            __hip_atomic_fetch_add(ksum + ((size_t)((b * 8 + head) * 32 + blk)) * 64 + d, s, __ATOMIC_RELAXED, __HIP_MEMORY_SCOPE_AGENT); } }
        }
    }
};

struct EpiSig {
    static constexpr bool PERM = true, AFTER_DRAIN = false;
    bf16_t* O; int ldc; const float* ssq;
    __device__ __forceinline__ void operator()(const f32x4 (&acc)[2][2][4][2], const Unit& u, int wr, int wc, int fr, int fq) const {
        const int row0 = u.pm * BM + wr * 64 + fr, col0 = u.pn * BM + wc * 32 + 8 * fq;
#pragma unroll
        for (int ai = 0; ai < 2; ++ai)
#pragma unroll
            for (int m = 0; m < 4; ++m) { const int row = row0 + ai * HALF + m * 16; const float r = row_rstd(ssq, row); bf16_t* rowp = O + (size_t)row * ldc + col0;
#pragma unroll
                for (int bj = 0; bj < 2; ++bj) { f32x4 v0 = acc[ai][bj][m][0] * r, v1 = acc[ai][bj][m][1] * r;
#pragma unroll
                    for (int j = 0; j < 4; ++j) { v0[j] = sigmoid_f(v0[j]); v1[j] = sigmoid_f(v1[j]); }
                    u32x4 w; w.x = cvt_pk_bf16(v0[0], v0[1]); w.y = cvt_pk_bf16(v0[2], v0[3]); w.z = cvt_pk_bf16(v1[0], v1[1]); w.w = cvt_pk_bf16(v1[2], v1[3]);
                    *(u32x4*)(rowp + bj * HALF) = w; } }
    }
};

template <bool ADD> struct EpiGate {
    static constexpr bool PERM = true, AFTER_DRAIN = false;
    const bf16_t* SIG; bf16_t* O; int ldc;
    __device__ __forceinline__ void operator()(const f32x4 (&acc)[2][2][4][2], const Unit& u, int wr, int wc, int fr, int fq) const {
        const int row0 = u.pm * BM + wr * 64 + fr, col0 = u.pn * BM + wc * 32 + 8 * fq;
#pragma unroll
        for (int ai = 0; ai < 2; ++ai)
#pragma unroll
            for (int m = 0; m < 4; ++m) { const size_t off = (size_t)(row0 + ai * HALF + m * 16) * ldc + col0;
#pragma unroll
                for (int bj = 0; bj < 2; ++bj) { const u32x4 sg = *(const u32x4*)(SIG + off + bj * HALF); f32x4 v0 = acc[ai][bj][m][0], v1 = acc[ai][bj][m][1];
                    v0[0] *= bf_lo(sg.x); v0[1] *= bf_hi(sg.x); v0[2] *= bf_lo(sg.y); v0[3] *= bf_hi(sg.y); v1[0] *= bf_lo(sg.z); v1[1] *= bf_hi(sg.z); v1[2] *= bf_lo(sg.w); v1[3] *= bf_hi(sg.w);
                    if (ADD) { const u32x4 pv = *(const u32x4*)(O + off + bj * HALF);
                        v0[0] += bf_lo(pv.x); v0[1] += bf_hi(pv.x); v0[2] += bf_lo(pv.y); v0[3] += bf_hi(pv.y); v1[0] += bf_lo(pv.z); v1[1] += bf_hi(pv.z); v1[2] += bf_lo(pv.w); v1[3] += bf_hi(pv.w); }
                    u32x4 w; w.x = cvt_pk_bf16(v0[0], v0[1]); w.y = cvt_pk_bf16(v0[2], v0[3]); w.z = cvt_pk_bf16(v1[0], v1[1]); w.w = cvt_pk_bf16(v1[2], v1[3]);
                    *(u32x4*)(O + off + bj * HALF) = w; }
                asm volatile("" ::: "memory"); }
    }
};

template <class Epi, class Sched, bool ALIGN_EPI = false, bool SP2 = false>
__device__ __forceinline__ void gemm_phase(PG8_LAS unsigned char* lds, const Gemm g, const Sched& S, const Epi& E) {
    int tid_ = threadIdx.x; asm volatile("" : "+v"(tid_));
    const int tid = tid_, wid = __builtin_amdgcn_readfirstlane(tid >> 6), lane = tid & 63, wr = wid >> 2, wc = wid & 3, fr = lane & 15, fq = lane >> 4;
    int K = g.K; asm volatile("" : "+s"(K)); const int nt = K / BK;
    unsigned voffA[2], voffB[2];
#pragma unroll
    for (int i = 0; i < 2; ++i) { int R, C; stage_rc(tid * 16 + i * 8192, R, C); const int Rb = Epi::PERM ? ((R & ~31) + perm32(R & 31)) : R;
        voffA[i] = (unsigned)(R * K + C) * 2u; voffB[i] = (unsigned)(Rb * K + C) * 2u; }
    const size_t kstep = (size_t)(BK * 2);
    const size_t hstep = (size_t)HALF * K * 2;
    const size_t tstep = 2 * hstep;
    const unsigned ldsw = (unsigned)wid * 1024u;
    const int aoff = lds_byte(wr * 64 + fr, fq * 8), boff = lds_byte(wc * 32 + fr, fq * 8);
#define PG8_SA(b, h) (((b) * 2 + (h)) * HTB)
#define PG8_SB(b, h) ((4 + (b) * 2 + (h)) * HTB)
#define PG8_STAGE(bufoff, gbase, voff) do { _Pragma("unroll") for (int _i = 0; _i < 2; ++_i) \
        __builtin_amdgcn_global_load_lds((const unsigned*)((const char*)(gbase) + (voff)[_i]), (PG8_LAS unsigned*)(lds + (bufoff) + ldsw + _i * 8192), 16, 0, 0); } while (0)
#define PG8_LDA(dst, b, h) do { _Pragma("unroll") for (int m = 0; m < 4; ++m) _Pragma("unroll") for (int k = 0; k < 2; ++k) dst[m][k] = *(const PG8_LAS bf16x8*)(lds + PG8_SA(b, h) + aoff + m * 2048 + k * 1024); } while (0)
#define PG8_LDB(dst, b, h) do { _Pragma("unroll") for (int n = 0; n < 2; ++n) _Pragma("unroll") for (int k = 0; k < 2; ++k) dst[n][k] = *(const PG8_LAS bf16x8*)(lds + PG8_SB(b, h) + boff + n * 2048 + k * 1024); } while (0)
#define PG8_MMA(ai, bj, At, Bt) do { __builtin_amdgcn_s_setprio(1); _Pragma("unroll") for (int m = 0; m < 4; ++m) _Pragma("unroll") for (int n = 0; n < 2; ++n) _Pragma("unroll") for (int k = 0; k < 2; ++k) \
        acc[ai][bj][m][n] = __builtin_amdgcn_mfma_f32_16x16x32_bf16(Bt[n][k], At[m][k], acc[ai][bj][m][n], 0, 0, 0); __builtin_amdgcn_s_setprio(0); } while (0)
#define PG8_WAIT_V(n) asm volatile("s_waitcnt vmcnt(" #n ")" ::: "memory")
#define PG8_WAIT_L(n) asm volatile("s_waitcnt lgkmcnt(" #n ")" ::: "memory")
#define PG8_BAR __builtin_amdgcn_s_barrier()
#define PG8_SCHED __builtin_amdgcn_sched_barrier(0)
    Unit cur, nxt; int ui = 0;
    if (!S.next(0, cur)) return;
    f32x4 acc[2][2][4][2];
#pragma unroll
    for (int a = 0; a < 2; ++a)
#pragma unroll
        for (int b = 0; b < 2; ++b)
#pragma unroll
            for (int m = 0; m < 4; ++m)
#pragma unroll
                for (int n = 0; n < 2; ++n) acc[a][b][m][n] = (f32x4){0.f, 0.f, 0.f, 0.f};
    bf16x8 At[4][2], B0[2][2], B1[2][2];
    const char* cA = (const char*)g.A + (size_t)cur.pm * tstep; const char* cB = (const char*)g.Bt + (size_t)cur.pn * tstep;
    S.a_ready(cur);
    if constexpr (SP2) {
        PG8_STAGE(PG8_SB(0, 0), cB, voffB); PG8_STAGE(PG8_SB(0, 1), cB + hstep, voffB); PG8_STAGE(PG8_SA(0, 0), cA, voffA); PG8_STAGE(PG8_SA(0, 1), cA + hstep, voffA);
        if (wr == 1) PG8_BAR;
        PG8_WAIT_V(2); PG8_BAR;
        PG8_STAGE(PG8_SB(1, 0), cB + kstep, voffB); PG8_STAGE(PG8_SA(1, 0), cA + kstep, voffA); PG8_STAGE(PG8_SB(1, 1), cB + hstep + kstep, voffB);
        PG8_WAIT_V(6); PG8_BAR;
    } else {
        PG8_STAGE(PG8_SB(0, 0), cB, voffB); PG8_STAGE(PG8_SA(0, 0), cA, voffA); PG8_STAGE(PG8_SB(0, 1), cB + hstep, voffB); PG8_STAGE(PG8_SA(0, 1), cA + hstep, voffA);
        if (wr == 1) PG8_BAR;
        PG8_WAIT_V(4); PG8_BAR;
        PG8_STAGE(PG8_SB(1, 0), cB + kstep, voffB); PG8_STAGE(PG8_SA(1, 0), cA + kstep, voffA); PG8_STAGE(PG8_SB(1, 1), cB + hstep + kstep, voffB);
        PG8_WAIT_V(6); PG8_BAR;
    }
    for (;;) {
        const bool has_next = S.next(ui + 1, nxt);
        const char* nA = has_next ? (const char*)g.A + (size_t)nxt.pm * tstep : cA; const char* nB = has_next ? (const char*)g.Bt + (size_t)nxt.pn * tstep : cB;
        for (int t = 0; t < nt; t += 2) {
            const bool last = (t == nt - 2);
            const char* a1 = cA + (size_t)(t + 1) * kstep;
            const char* a2 = last ? nA : cA + (size_t)(t + 2) * kstep; const char* b2 = last ? nB : cB + (size_t)(t + 2) * kstep;
            const char* a3 = a2 + kstep; const char* b3 = b2 + kstep;
            if (last && has_next) S.a_ready(nxt);
            if constexpr (SP2) {
            PG8_LDB(B0, 0, 0); PG8_LDB(B1, 0, 1); PG8_SCHED; PG8_LDA(At, 0, 0); PG8_STAGE(PG8_SA(1, 1), a1 + hstep, voffA);
            PG8_WAIT_V(8); PG8_WAIT_L(0); PG8_BAR; PG8_MMA(0, 0, At, B0); PG8_MMA(0, 1, At, B1); PG8_BAR; PG8_SCHED;
            PG8_LDA(At, 0, 1); PG8_STAGE(PG8_SB(0, 0), b2, voffB); PG8_STAGE(PG8_SB(0, 1), b2 + hstep, voffB); PG8_STAGE(PG8_SA(0, 0), a2, voffA);
            PG8_WAIT_V(8); PG8_WAIT_L(0); PG8_BAR; PG8_MMA(1, 0, At, B0); PG8_MMA(1, 1, At, B1); PG8_BAR; PG8_SCHED;
            PG8_LDB(B0, 1, 0); PG8_LDB(B1, 1, 1); PG8_SCHED; PG8_LDA(At, 1, 0); PG8_STAGE(PG8_SA(0, 1), a2 + hstep, voffA);
            PG8_WAIT_V(8); PG8_WAIT_L(0); PG8_BAR; PG8_MMA(0, 0, At, B0); PG8_MMA(0, 1, At, B1); PG8_BAR; PG8_SCHED;
            PG8_LDA(At, 1, 1); PG8_STAGE(PG8_SB(1, 0), b3, voffB); PG8_STAGE(PG8_SB(1, 1), b3 + hstep, voffB); PG8_STAGE(PG8_SA(1, 0), a3, voffA);
            PG8_WAIT_V(8); PG8_WAIT_L(0); PG8_BAR; PG8_MMA(1, 0, At, B0); PG8_MMA(1, 1, At, B1); PG8_BAR; PG8_SCHED;
            } else {
            PG8_LDB(B0, 0, 0); PG8_SCHED; PG8_LDA(At, 0, 0); PG8_STAGE(PG8_SA(1, 1), a1 + hstep, voffA);
            PG8_WAIT_L(8); PG8_BAR; PG8_WAIT_L(0); PG8_MMA(0, 0, At, B0); PG8_BAR; PG8_SCHED;
            PG8_LDB(B1, 0, 1); PG8_STAGE(PG8_SB(0, 0), b2, voffB);
            PG8_BAR; PG8_WAIT_L(0); PG8_MMA(0, 1, At, B1); PG8_BAR;
            PG8_LDA(At, 0, 1); PG8_STAGE(PG8_SA(0, 0), a2, voffA);
            PG8_BAR; PG8_WAIT_L(0); PG8_MMA(1, 0, At, B0); PG8_BAR; PG8_SCHED;
            PG8_STAGE(PG8_SB(0, 1), b2 + hstep, voffB);
            PG8_WAIT_V(6); PG8_BAR; PG8_MMA(1, 1, At, B1); PG8_BAR;
            PG8_LDB(B0, 1, 0); PG8_SCHED; PG8_LDA(At, 1, 0); PG8_STAGE(PG8_SA(0, 1), a2 + hstep, voffA);
            PG8_WAIT_L(8); PG8_BAR; PG8_WAIT_L(0); PG8_MMA(0, 0, At, B0); PG8_BAR; PG8_SCHED;
            PG8_LDB(B1, 1, 1); PG8_STAGE(PG8_SB(1, 0), b3, voffB);
            PG8_BAR; PG8_WAIT_L(0); PG8_MMA(0, 1, At, B1); PG8_BAR;
            PG8_LDA(At, 1, 1); PG8_STAGE(PG8_SA(1, 0), a3, voffA);
            PG8_BAR; PG8_WAIT_L(0); PG8_MMA(1, 0, At, B0); PG8_BAR; PG8_SCHED;
            PG8_STAGE(PG8_SB(1, 1), b3 + hstep, voffB);
            PG8_WAIT_V(6); PG8_BAR; PG8_MMA(1, 1, At, B1); PG8_BAR;
            }
        }
        if constexpr (ALIGN_EPI) { if (wr == 0) PG8_BAR; }
        if constexpr (!Epi::AFTER_DRAIN) { E(acc, cur, wr, wc, fr, fq); S.done(cur); }
        if (!has_next) break;
#pragma unroll
        for (int a = 0; a < 2; ++a)
#pragma unroll
            for (int b = 0; b < 2; ++b)
#pragma unroll
                for (int m = 0; m < 4; ++m)
#pragma unroll
                    for (int n = 0; n < 2; ++n) acc[a][b][m][n] = (f32x4){0.f, 0.f, 0.f, 0.f};
        cur = nxt; cA = nA; cB = nB; ++ui;
        if constexpr (ALIGN_EPI) { if (wr == 1) PG8_BAR; }
    }
    PG8_WAIT_V(0);
    if constexpr (!ALIGN_EPI) { if (wr == 0) PG8_BAR; }
    PG8_BAR;
    if constexpr (Epi::AFTER_DRAIN) { E.fused(acc, cur, wr, wc, fr, fq, lds, wid, lane); S.done(cur); }
#undef PG8_SA
#undef PG8_SB
#undef PG8_STAGE
#undef PG8_LDA
#undef PG8_LDB
#undef PG8_MMA
#undef PG8_WAIT_V
#undef PG8_WAIT_L
#undef PG8_BAR
#undef PG8_SCHED
}
}
#define GAS __attribute__((address_space(1)))
#define LAS __attribute__((address_space(3)))
typedef unsigned short bf16;
typedef unsigned v4u __attribute__((ext_vector_type(4)));
typedef float f32x4 __attribute__((ext_vector_type(4)));
typedef short bf16x8 __attribute__((ext_vector_type(8)));
typedef GAS unsigned gu32;
typedef GAS unsigned long long gu64;
#define RLX_AGENT __ATOMIC_RELAXED, __HIP_MEMORY_SCOPE_AGENT
#define LDS_WAIT() asm volatile("s_waitcnt lgkmcnt(0)" ::: "memory")
#define VM_WAIT() asm volatile("s_waitcnt vmcnt(0)" ::: "memory")
__device__ __forceinline__ unsigned long long rt() { return __builtin_amdgcn_s_memrealtime(); }
__device__ __forceinline__ unsigned f2bf(float f) { unsigned u = __builtin_bit_cast(unsigned, f); return (u + 0x7fffu + ((u >> 16) & 1u)) >> 16; }
__device__ __forceinline__ unsigned pk2(float lo, float hi) { return f2bf(lo) | (f2bf(hi) << 16); }

#define XB_TMO      128
#define XB_XCNT(j)  (256  + 64 * (j))
#define XB_XSUB(j)  (1280 + 64 * (j))
#define XB_XGEN(j)  (2304 + 64 * (j))
#define XB_TOP      3328
#define XB_TOPGEN   3392
#define XCD_BAR_WORDS 3456
#define XB_SPIN_CAP (1u << 18)

__device__ __forceinline__ unsigned xb_ld(unsigned* p)              { return __hip_atomic_load(p, __ATOMIC_RELAXED, __HIP_MEMORY_SCOPE_AGENT); }
__device__ __forceinline__ unsigned xb_add(unsigned* p, unsigned v) { return __hip_atomic_fetch_add(p, v, __ATOMIC_RELAXED, __HIP_MEMORY_SCOPE_AGENT); }
__device__ __forceinline__ unsigned xb_xcc_id() { return (unsigned)__builtin_amdgcn_s_getreg((3 << 11) | 20) & 0xFu; }
#define XB_SPIN(cond, bar) do { unsigned _sp = 0; while (cond) { __builtin_amdgcn_s_sleep(1); \
    if ((++_sp & 255u) == 0u) { if (xb_ld(&(bar)[XB_TMO])) break; if (_sp > XB_SPIN_CAP) { atomicAdd(&(bar)[XB_TMO], 1u); break; } } } } while (0)

struct XcdBarrier {
    unsigned* bar; unsigned x;
    volatile LAS unsigned* st;
};

__device__ __forceinline__ XcdBarrier xcd_barrier_post(unsigned* bar, volatile LAS unsigned* st) {
    XcdBarrier b; b.bar = bar; b.x = xb_xcc_id(); b.st = st;
    if (threadIdx.x == 0) (void)xb_add(&bar[XB_XCNT(b.x)], 1u);
    return b;
}
__device__ __forceinline__ void xcd_barrier_complete(unsigned* bar, unsigned x, unsigned& nloc, unsigned& nx) {
    const unsigned G = gridDim.x * gridDim.y * gridDim.z;
    unsigned sum, cnt, mine, sp = 0u;
    for (;;) {
        sum = 0u; cnt = 0u; mine = 0u;
#pragma unroll
        for (unsigned j = 0; j < 16; ++j) { const unsigned c = xb_ld(&bar[XB_XCNT(j)]); sum += c; cnt += (c > 0u) ? 1u : 0u; mine = (j == x) ? c : mine; }
        if (sum == G) break;
        __builtin_amdgcn_s_sleep(1);
        if ((++sp & 255u) == 0u) { if (xb_ld(&bar[XB_TMO])) break; if (sp > XB_SPIN_CAP) { atomicAdd(&bar[XB_TMO], 1u); break; } }
    }
    nloc = mine > 0u ? mine : 1u; nx = cnt > 0u ? cnt : 1u;
}

__device__ __forceinline__ void xcd_barrier(const XcdBarrier& b) {
    asm volatile("s_waitcnt vmcnt(0)" ::: "memory");
    __syncthreads();
    if (threadIdx.x == 0) {
        unsigned* bar = b.bar;
        __builtin_amdgcn_s_waitcnt(0);
        unsigned nloc = b.st[0], nx = b.st[1];
        if (nloc == 0u) { xcd_barrier_complete(bar, b.x, nloc, nx); b.st[0] = nloc; b.st[1] = nx; }
        const unsigned old = xb_add(&bar[XB_XSUB(b.x)], 1u);
        const unsigned gen = old / nloc;
        if (old + 1u == (gen + 1u) * nloc) {
            __builtin_amdgcn_fence(__ATOMIC_RELEASE, "agent");
            asm volatile("s_waitcnt vmcnt(0)" ::: "memory");
            const unsigned og = xb_add(&bar[XB_TOP], 1u);
            const unsigned tg = og / nx;
            if (og + 1u == (tg + 1u) * nx) xb_add(&bar[XB_TOPGEN], 1u);
            else XB_SPIN(xb_ld(&bar[XB_TOPGEN]) == tg, bar);
            __builtin_amdgcn_fence(__ATOMIC_ACQUIRE, "agent");
            xb_add(&bar[XB_XGEN(b.x)], 1u);
            asm volatile("s_waitcnt vmcnt(0)" ::: "memory");
        } else {
            XB_SPIN(xb_ld(&bar[XB_XGEN(b.x)]) == gen, bar);
            __builtin_amdgcn_fence(__ATOMIC_ACQUIRE, "agent");
            asm volatile("s_waitcnt vmcnt(0)" ::: "memory");
        }
    }
    __syncthreads();
}

namespace att {
typedef short bf16x8 __attribute__((ext_vector_type(8)));
typedef short s16x4 __attribute__((ext_vector_type(4)));
typedef float f32x16 __attribute__((ext_vector_type(16)));
typedef unsigned u32x4 __attribute__((ext_vector_type(4)));
typedef short v4i16_t __attribute__((ext_vector_type(4)));
typedef float f32x2_t __attribute__((ext_vector_type(2)));
typedef __bf16 bf16x2_t __attribute__((ext_vector_type(2)));
typedef unsigned short bfraw;
#define ALAS __attribute__((address_space(3)))
__device__ __forceinline__ int crow(int r, int hi) { return (r & 3) + 8 * (r >> 2) + 4 * hi; }
__device__ __forceinline__ unsigned cvtpk(float lo, float hi) { f32x2_t v = {lo, hi}; bf16x2_t b = __builtin_convertvector(v, bf16x2_t); return __builtin_bit_cast(unsigned, b); }
__device__ __forceinline__ float swapmax(float v) { auto rr = __builtin_amdgcn_permlane32_swap(__float_as_uint(v), __float_as_uint(v), false, false); return fmaxf(__uint_as_float(rr[0]), __uint_as_float(rr[1])); }
__device__ __forceinline__ float swapsum(float v) { auto rr = __builtin_amdgcn_permlane32_swap(__float_as_uint(v), __float_as_uint(v), false, false); return __uint_as_float(rr[0]) + __uint_as_float(rr[1]); }
__device__ __forceinline__ s16x4 vtr(ALAS const unsigned char* p) { return __builtin_bit_cast(s16x4, __builtin_amdgcn_ds_read_tr16_b64_v4i16((ALAS v4i16_t*)p)); }
__device__ __forceinline__ int clampi(int v, int lo, int hi) { return v < lo ? lo : (v > hi ? hi : v); }

__device__ __forceinline__ float attn_tile(const bfraw* Qrow, const bfraw* Kp, const bfraw* Vp, long kstride, int kidx0, int nch, int kmax, int qpos, int dlo, int dhi, float ns2,
                                           ALAS unsigned char* vimg, ALAS bfraw* stg, ALAS float* wsf, int lane) {
    const int r32 = lane & 31, hi = lane >> 5;
    bf16x8 qr[4];
#pragma unroll
    for (int d0 = 0; d0 < 4; ++d0) qr[d0] = *(const bf16x8*)(Qrow + 16 * d0 + 8 * hi);
    f32x16 o0, o1;
#pragma unroll
    for (int r = 0; r < 16; ++r) { o0[r] = 0.f; o1[r] = 0.f; }
    float m = -INFINITY, l = 0.f;
    ALAS const unsigned char* vb = vimg + ((lane >> 4) & 1) * 32 + (lane & 3) * 8 + (4 * hi + ((lane & 15) >> 2)) * 64;
    const int vkey = lane >> 3, vc16 = lane & 7;
    ALAS unsigned char* vw = vimg + (vc16 >> 2) * 4096 + (vc16 & 3) * 16;
    for (int ch = 0; ch < nch; ++ch) {
        const int k0 = kidx0 + 64 * ch;
        if (k0 + 63 < 0) continue;
        const int ka = clampi(k0 + r32, 0, kmax - 1), kb = clampi(k0 + 32 + r32, 0, kmax - 1);
        const bfraw* kpa = Kp + (long)ka * kstride + 8 * hi; const bfraw* kpb = Kp + (long)kb * kstride + 8 * hi;
        bf16x8 kfa[4], kfb[4];
#pragma unroll
        for (int d0 = 0; d0 < 4; ++d0) { kfa[d0] = *(const bf16x8*)(kpa + 16 * d0); kfb[d0] = *(const bf16x8*)(kpb + 16 * d0); }
        u32x4 vr[8];
#pragma unroll
        for (int i = 0; i < 8; ++i) { const int kk = clampi(k0 + 8 * i + vkey, 0, kmax - 1); vr[i] = *(const u32x4*)(Vp + (long)kk * kstride + vc16 * 8); }
        f32x16 p0, p1;
#pragma unroll
        for (int r = 0; r < 16; ++r) { p0[r] = 0.f; p1[r] = 0.f; }
#pragma unroll
        for (int d0 = 0; d0 < 4; ++d0) { p0 = __builtin_amdgcn_mfma_f32_32x32x16_bf16(kfa[d0], qr[d0], p0, 0, 0, 0); p1 = __builtin_amdgcn_mfma_f32_32x32x16_bf16(kfb[d0], qr[d0], p1, 0, 0, 0); }
        asm volatile("" ::: "memory");
#pragma unroll
        for (int i = 0; i < 8; ++i) { const int key = 8 * i + vkey; *(ALAS u32x4*)(vw + (key >> 4) * 1024 + (key & 15) * 64) = vr[i]; }
        asm volatile("" ::: "memory");
        float mx = -INFINITY;
#pragma unroll
        for (int r = 0; r < 16; ++r) { const int kk = k0 + crow(r, hi); const int d = qpos - kk, d2 = d - 32;
            const bool ok0 = (d >= dlo) && (d <= dhi) && (kk >= 0), ok1 = (d2 >= dlo) && (d2 <= dhi) && (kk + 32 >= 0);
            p0[r] = ok0 ? p0[r] + ns2 * (float)d : -INFINITY; p1[r] = ok1 ? p1[r] + ns2 * (float)d2 : -INFINITY;
            mx = fmaxf(mx, fmaxf(p0[r], p1[r])); }
        mx = swapmax(mx);
        const float mn = fmaxf(m, mx), mu = (mn == -INFINITY) ? 0.f : mn;
        const float alpha = __builtin_amdgcn_exp2f(m - mu);
        m = mn;
        float ls = 0.f;
#pragma unroll
        for (int r = 0; r < 16; ++r) { p0[r] = __builtin_amdgcn_exp2f(p0[r] - mu); p1[r] = __builtin_amdgcn_exp2f(p1[r] - mu); ls += p0[r] + p1[r]; }
        l = l * alpha + ls;
        if (hi == 0) wsf[r32] = alpha;
#pragma unroll
        for (int r = 0; r < 16; ++r) { const float a = wsf[crow(r, hi)]; o0[r] *= a; o1[r] *= a; }
        u32x4 pw[4];
#pragma unroll
        for (int s = 0; s < 2; ++s) { pw[s] = (u32x4){cvtpk(p0[8 * s], p0[8 * s + 1]), cvtpk(p0[8 * s + 2], p0[8 * s + 3]), cvtpk(p0[8 * s + 4], p0[8 * s + 5]), cvtpk(p0[8 * s + 6], p0[8 * s + 7])};
            pw[2 + s] = (u32x4){cvtpk(p1[8 * s], p1[8 * s + 1]), cvtpk(p1[8 * s + 2], p1[8 * s + 3]), cvtpk(p1[8 * s + 4], p1[8 * s + 5]), cvtpk(p1[8 * s + 6], p1[8 * s + 7])}; }
#pragma unroll
        for (int s = 0; s < 4; ++s) {
            const s16x4 a0 = vtr(vb + s * 1024), a1 = vtr(vb + s * 1024 + 512), b0 = vtr(vb + 4096 + s * 1024), b1 = vtr(vb + 4096 + s * 1024 + 512);
            const bf16x8 v0 = (bf16x8){a0[0], a0[1], a0[2], a0[3], a1[0], a1[1], a1[2], a1[3]}, v1 = (bf16x8){b0[0], b0[1], b0[2], b0[3], b1[0], b1[1], b1[2], b1[3]};
            const bf16x8 pa = __builtin_bit_cast(bf16x8, pw[s]);
            o0 = __builtin_amdgcn_mfma_f32_32x32x16_bf16(pa, v0, o0, 0, 0, 0);
            o1 = __builtin_amdgcn_mfma_f32_32x32x16_bf16(pa, v1, o1, 0, 0, 0);
        }
        asm volatile("" ::: "memory");
    }
    asm volatile("" ::: "memory");
    const float lt = swapsum(l);
    const float rl = lt > 0.f ? 1.0f / lt : 0.f;
    if (hi == 0) wsf[32 + r32] = rl;
#pragma unroll
    for (int r = 0; r < 16; ++r) { const int q = crow(r, hi); const float a = wsf[32 + q];
        const unsigned w0 = cvtpk(o0[r] * a, 0.f), w1 = cvtpk(o1[r] * a, 0.f);
        stg[q * 64 + r32] = (bfraw)(w0 & 0xffffu); stg[q * 64 + 32 + r32] = (bfraw)(w1 & 0xffffu); }
    asm volatile("" ::: "memory");
    return m + __builtin_amdgcn_logf(lt);
}
}

constexpr int NWAVES = 8;
constexpr int BATCH = 2, SEQ = 8192, D = 1024, FF = 2816, M = BATCH * SEQ;
constexpr int NQKV = 3840, NIN = 5888;
constexpr float QSCALE = 0.125f * 1.4426950408889634f;

constexpr size_t MiB = 1u << 20, KiB = 1u << 10;
constexpr size_t WS_CTL = 0, CTL_ZERO_BYTES = 1 * MiB;
constexpr size_t WS_W1C = 2 * MiB;
constexpr size_t WS_W1D = 13 * MiB;
constexpr size_t WS_WIN = WS_W1D + 5 * MiB + 512 * KiB;
constexpr size_t WS_WUA = 30 * MiB;
constexpr size_t WS_WUB = WS_WUA + 512 * KiB;
constexpr size_t WS_WO = WS_WUB + 1 * MiB;
constexpr size_t WS_W2C = WS_WO + 2 * MiB;
constexpr size_t WS_W2D = WS_W2C + 11 * MiB;
constexpr size_t WS_XB = 50 * MiB;
constexpr size_t WS_BIG = 82 * MiB;
constexpr size_t WS_H = WS_BIG;
constexpr size_t WS_QA = WS_BIG;
constexpr size_t WS_QB = WS_QA + 72 * MiB;
constexpr size_t WS_YA = 202 * MiB;
constexpr size_t WS_YB = 210 * MiB;
constexpr size_t WS_SCR = 226 * MiB;
constexpr size_t SCR_STRIDE = 104 * KiB, SCR_LSE = 96 * KiB;
constexpr size_t WS_SCR3 = WS_W1C;
constexpr size_t SCR3_STRIDE = 33 * KiB, SCR3_LSE = 32 * KiB;
constexpr size_t WS_SIGA = WS_BIG, WS_SIGB = WS_BIG + 32 * MiB, WS_MG = WS_BIG + 64 * MiB;
constexpr size_t WS_END = 252 * MiB;
static_assert(WS_W2D + 5 * MiB + 512 * KiB <= WS_XB && WS_SCR + 256 * SCR_STRIDE <= WS_END && 256 * SCR3_STRIDE <= 11 * MiB && WS_MG + 32 * MiB <= WS_YA, "d_ws map");
constexpr int CW_TMO = 0, CW_CODE = 1;
constexpr int CW_BAR = 4096;
constexpr int CW_QUEUE = 8192;
constexpr size_t CB_SSQ0 = 256 * KiB, CB_SSQ1 = 320 * KiB, CB_SSQ2 = 384 * KiB, CB_SSQ3 = 448 * KiB, CB_KSUM = 512 * KiB;

constexpr int RING_OFF = 0, RING_BYTES = 131072;
constexpr int LDSCTL_OFF = RING_BYTES, MISC_OFF = LDSCTL_OFF + 320;
constexpr int LDS_BYTES = 147456;
constexpr int AL_VIMG = 0, AL_STG = 65536, AL_WSF = 98304, AL_LIST = 100352, AL_CNT = 116736, AL_TCTR = 116864, AL_ITEM = 116868, AL_KS = 117760;
static_assert(AL_KS + 8192 <= RING_BYTES, "attention LDS map");

__device__ __forceinline__ float wave_sum(float v) {
#pragma unroll
    for (int o = 1; o < 64; o <<= 1) v += __shfl_xor(v, o);
    return v;
}
__device__ __forceinline__ void tr_item(const float* W, int K, int N, bf16* WT, int out_row0, int k0, int n0, const float* gain, float cs, LAS float* scr, int lane) {
    const int r = lane >> 4, c4 = lane & 15;
    f32x4 v[16];
#pragma unroll
    for (int i = 0; i < 16; ++i) v[i] = *(const GAS f32x4*)(W + (size_t)(k0 + 4 * i + r) * N + n0 + 4 * c4);
#pragma unroll
    for (int i = 0; i < 16; ++i) { const int k = 4 * i + r; const float g = gain ? gain[k0 + k] * cs : cs;
        *(LAS f32x4*)(scr + k * 64 + ((4 * c4) ^ (8 * ((k >> 3) & 7)))) = v[i] * g; }
    LDS_WAIT(); asm volatile("" ::: "memory");
    const int c = lane & 7;
#pragma unroll
    for (int j = 0; j < 8; ++j) { const int n = (lane >> 3) + 8 * j; const LAS float* s = scr + (8 * c) * 64 + (n ^ (8 * c));
        v4u o; o.x = pk2(s[0 * 64], s[1 * 64]); o.y = pk2(s[2 * 64], s[3 * 64]); o.z = pk2(s[4 * 64], s[5 * 64]); o.w = pk2(s[6 * 64], s[7 * 64]);
        *(GAS v4u*)(WT + (size_t)(out_row0 + n) * K + k0 + 8 * c) = o; }
    LDS_WAIT(); asm volatile("" ::: "memory");
}

struct Args { const float* in[15]; float* out; unsigned char* ws; };

struct Scr { bf16* O012; float* L012; bf16* O3; float* L3; };
__device__ __forceinline__ bf16* scr_o(const Scr& s, int slot, int q) { return slot < 3 ? s.O012 + ((size_t)slot * 256 + q) * 64 : s.O3 + (size_t)q * 64; }
__device__ __forceinline__ float* scr_l(const Scr& s, int slot, int q) { return slot < 3 ? s.L012 + slot * 256 + q : s.L3 + q; }

__device__ __forceinline__ void merge_slots(const Scr& sc, unsigned mask, bf16* Y, int ldy, int tid) {
    asm volatile("" : "+v"(tid));
    const int q = tid >> 1, half = tid & 1;
    float L[4], mxl = -INFINITY;
#pragma unroll
    for (int s = 0; s < 4; ++s) { L[s] = -INFINITY; if (mask & (1u << s)) { L[s] = *scr_l(sc, s, q); mxl = fmaxf(mxl, L[s]); } }
    float acc[32];
#pragma unroll
    for (int i = 0; i < 32; ++i) acc[i] = 0.f;
    float den = 0.f;
#pragma unroll
    for (int s = 0; s < 4; ++s) if (mask & (1u << s)) {
        const float w = __builtin_amdgcn_exp2f(L[s] - mxl); den += w;
        const v4u* p = (const v4u*)(scr_o(sc, s, q) + half * 32);
#pragma unroll
        for (int i = 0; i < 4; ++i) { const v4u v = p[i];
            acc[8 * i + 0] += w * __uint_as_float(v.x << 16); acc[8 * i + 1] += w * __uint_as_float(v.x & 0xffff0000u);
            acc[8 * i + 2] += w * __uint_as_float(v.y << 16); acc[8 * i + 3] += w * __uint_as_float(v.y & 0xffff0000u);
            acc[8 * i + 4] += w * __uint_as_float(v.z << 16); acc[8 * i + 5] += w * __uint_as_float(v.z & 0xffff0000u);
            acc[8 * i + 6] += w * __uint_as_float(v.w << 16); acc[8 * i + 7] += w * __uint_as_float(v.w & 0xffff0000u); }
    }
    const float rd = 1.0f / den;
    v4u* o = (v4u*)(Y + (size_t)q * ldy + half * 32);
#pragma unroll
    for (int i = 0; i < 4; ++i) { v4u w; w.x = pk2(acc[8 * i] * rd, acc[8 * i + 1] * rd); w.y = pk2(acc[8 * i + 2] * rd, acc[8 * i + 3] * rd); w.z = pk2(acc[8 * i + 4] * rd, acc[8 * i + 5] * rd); w.w = pk2(acc[8 * i + 6] * rd, acc[8 * i + 7] * rd); o[i] = w; }
}

__device__ __forceinline__ void dsa_unit(int b, int j, int sp, const bf16* QA, const bf16* KA, const bf16* VA, bf16* YA, const Scr& sc, LAS unsigned char* lds, int tid, bool domerge) {
    asm volatile("" : "+v"(tid));
    const int lane = tid & 63, wave = __builtin_amdgcn_readfirstlane(tid >> 6), r32 = lane & 31, hi = lane >> 5;
    LAS unsigned char* vimg = lds + AL_VIMG + wave * 8192; LAS bf16* stg = (LAS bf16*)(lds + AL_STG + wave * 4096); LAS float* wsf = (LAS float*)(lds + AL_WSF + wave * 256);
    const int T0 = sp * 256;
    for (int T = wave; T < 32; T += NWAVES) {
        int g, dil, res, i0, nvalid;
        if (T < 8) { g = 0; dil = 1; res = 0; i0 = T0 + 32 * T; nvalid = 32; }
        else if (T < 16) { g = 1; dil = 4; res = (T - 8) >> 1; i0 = (T0 >> 2) + 32 * (T & 1); nvalid = 32; }
        else { g = 2; dil = 16; res = T - 16; i0 = T0 >> 4; nvalid = 16; }
        const int h = 4 * g + j;
        const float slope = __builtin_amdgcn_exp2f(-8.0f * (float)(h + 1) / 12.0f);
        const float ns2 = -slope * (float)dil * 1.4426950408889634f;
        const size_t base = ((size_t)b * SEQ + res) * 768 + (size_t)h * 64;
        const long kstride = (long)dil * 768;
        const int myrow = r32 & (nvalid - 1);
        const bf16* Qrow = QA + base + (size_t)(i0 + myrow) * kstride;
        const int kidx0 = i0 + nvalid - 192;
        const float lse = att::attn_tile(Qrow, KA + base, VA + base, kstride, kidx0, 3, SEQ / dil, i0 + myrow, 0, 128, ns2, vimg, stg, wsf, lane);
#pragma unroll
        for (int i = 0; i < 4; ++i) { const int row = i * 8 + (lane >> 3), chn = lane & 7;
            const v4u v = *(const LAS v4u*)(stg + row * 64 + chn * 8);
            if (row < nvalid) { const int q = (i0 + row) * dil + res - T0; *(v4u*)(scr_o(sc, g, q) + chn * 8) = v; } }
        if (hi == 0 && r32 < nvalid) { const int q = (i0 + r32) * dil + res - T0; *scr_l(sc, g, q) = lse; }
        asm volatile("" ::: "memory");
    }
    asm volatile("s_waitcnt vmcnt(0)" ::: "memory");
    __syncthreads();
    if (domerge) merge_slots(sc, 7u, YA + ((size_t)b * SEQ + T0) * 256 + j * 64, 256, tid);
    asm volatile("s_waitcnt vmcnt(0)" ::: "memory");
    __syncthreads();
}

__device__ __forceinline__ void moba_unit(int b, int h, int c, const bf16* QB, const bf16* KB, const bf16* VB, const float* ksum, bf16* YB, const Scr& sc, LAS unsigned char* lds, int tid, bool domerge) {
    asm volatile("" : "+v"(tid));
    const int lane = tid & 63, wave = __builtin_amdgcn_readfirstlane(tid >> 6), r32 = lane & 31, hi = lane >> 5;
    LAS unsigned char* vimg = lds + AL_VIMG + wave * 8192; LAS bf16* stg = (LAS bf16*)(lds + AL_STG + wave * 4096); LAS float* wsf = (LAS float*)(lds + AL_WSF + wave * 256);
    LAS unsigned short* LIST = (LAS unsigned short*)(lds + AL_LIST); LAS int* CNT = (LAS int*)(lds + AL_CNT); LAS int* TCTR = (LAS int*)(lds + AL_TCTR); LAS float* KS = (LAS float*)(lds + AL_KS);
    const float slope = __builtin_amdgcn_exp2f(-(float)(h + 1));
    const float ns2 = -slope * 1.4426950408889634f;
    const size_t hb = ((size_t)b * SEQ) * 512 + (size_t)h * 64;
    const int nsel = c < 3 ? c : 3;
    { const float* ks = ksum + ((size_t)(b * 8 + h) * 32) * 64; for (int i = tid; i < c * 64; i += NWAVES * 64) KS[i] = ks[i]; }
    if (tid < 32) CNT[tid] = 0;
    if (tid == 32) TCTR[0] = 0;
    __syncthreads();
    if (c > 0) {
        const int q = tid >> 1, half = tid & 1;
        float qf[32];
        { const v4u* qp = (const v4u*)(QB + hb + (size_t)(c * 256 + q) * 512 + half * 32);
#pragma unroll
          for (int i = 0; i < 4; ++i) { const v4u v = qp[i];
              qf[8 * i + 0] = __uint_as_float(v.x << 16); qf[8 * i + 1] = __uint_as_float(v.x & 0xffff0000u); qf[8 * i + 2] = __uint_as_float(v.y << 16); qf[8 * i + 3] = __uint_as_float(v.y & 0xffff0000u);
              qf[8 * i + 4] = __uint_as_float(v.z << 16); qf[8 * i + 5] = __uint_as_float(v.z & 0xffff0000u); qf[8 * i + 6] = __uint_as_float(v.w << 16); qf[8 * i + 7] = __uint_as_float(v.w & 0xffff0000u); } }
        float v1 = -INFINITY, v2 = -INFINITY, v3 = -INFINITY; int i1 = 0, i2 = 0, i3 = 0;
        for (int n = 0; n < c; ++n) {
            const LAS f32x4* kp = (const LAS f32x4*)(KS + n * 64 + half * 32);
            float dot = 0.f;
#pragma unroll
            for (int d4 = 0; d4 < 8; ++d4) { const f32x4 kv = kp[d4]; dot += qf[4 * d4] * kv[0] + qf[4 * d4 + 1] * kv[1] + qf[4 * d4 + 2] * kv[2] + qf[4 * d4 + 3] * kv[3]; }
            dot += __shfl_xor(dot, 1);
            if (dot > v1) { v3 = v2; i3 = i2; v2 = v1; i2 = i1; v1 = dot; i1 = n; }
            else if (dot > v2) { v3 = v2; i3 = i2; v2 = dot; i2 = n; }
            else if (dot > v3) { v3 = dot; i3 = n; }
        }
        if (half == 0) {
            { const int pos = atomicAdd((int*)(CNT + i1), 1); LIST[i1 * 256 + pos] = (unsigned short)(q | (0 << 8)); }
            if (nsel > 1) { const int pos = atomicAdd((int*)(CNT + i2), 1); LIST[i2 * 256 + pos] = (unsigned short)(q | (1 << 8)); }
            if (nsel > 2) { const int pos = atomicAdd((int*)(CNT + i3), 1); LIST[i3 * 256 + pos] = (unsigned short)(q | (2 << 8)); }
        }
    }
    __syncthreads();
    int endp = (lane < 32 && lane < c) ? ((CNT[lane & 31] + 31) >> 5) : 0;
#pragma unroll
    for (int off = 1; off < 32; off <<= 1) { const int t = __shfl_up(endp, off); if ((lane & 31) >= off) endp += t; }
    const int total = __shfl(endp, 31);
    {
        const bf16* Qrow = QB + hb + (size_t)(c * 256 + 32 * wave + r32) * 512;
        const int nch = (32 * wave + 32 + 63) >> 6;
        const float lse = att::attn_tile(Qrow, KB + hb + (size_t)c * 256 * 512, VB + hb + (size_t)c * 256 * 512, 512, 0, nch, 256, 32 * wave + r32, 0, 1 << 28, ns2, vimg, stg, wsf, lane);
#pragma unroll
        for (int i = 0; i < 4; ++i) { const int row = i * 8 + (lane >> 3), chn = lane & 7; const v4u v = *(const LAS v4u*)(stg + row * 64 + chn * 8); *(v4u*)(scr_o(sc, 3, 32 * wave + row) + chn * 8) = v; }
        if (hi == 0) *scr_l(sc, 3, 32 * wave + r32) = lse;
        asm volatile("" ::: "memory");
    }
    for (;;) {
        int T = 0; if (lane == 0) T = atomicAdd((int*)TCTR, 1);
        T = __shfl(T, 0);
        if (T >= total) break;
        const unsigned long long bal = __ballot(lane < 32 && endp <= T);
        const int n = __popcll(bal);
        const int prev = n ? __shfl(endp, n - 1) : 0;
        const int k = T - prev, cntn = CNT[n];
        const int idx = 32 * k + r32, e = LIST[n * 256 + (idx < cntn ? idx : cntn - 1)], q = e & 255;
        const bf16* Qrow = QB + hb + (size_t)(c * 256 + q) * 512;
        const float lse = att::attn_tile(Qrow, KB + hb + (size_t)n * 256 * 512, VB + hb + (size_t)n * 256 * 512, 512, 0, 4, 256, (c - n) * 256 + q, -(1 << 28), 1 << 28, ns2, vimg, stg, wsf, lane);
#pragma unroll
        for (int i = 0; i < 4; ++i) { const int row = i * 8 + (lane >> 3), chn = lane & 7; const v4u v = *(const LAS v4u*)(stg + row * 64 + chn * 8);
            const int id2 = 32 * k + row; if (id2 < cntn) { const int e2 = LIST[n * 256 + id2]; *(v4u*)(scr_o(sc, e2 >> 8, e2 & 255) + chn * 8) = v; } }
        if (hi == 0 && idx < cntn) *scr_l(sc, e >> 8, q) = lse;
        asm volatile("" ::: "memory");
    }
    asm volatile("s_waitcnt vmcnt(0)" ::: "memory");
    __syncthreads();
    if (domerge) merge_slots(sc, ((1u << nsel) - 1u) | 8u, YB + ((size_t)b * SEQ + c * 256) * 512 + h * 64, 512, tid);
    asm volatile("s_waitcnt vmcnt(0)" ::: "memory");
    __syncthreads();
}

#ifndef SKIP_MIXER
#define SKIP_MIXER 0
#endif
#ifndef SKIP_DSA
#define SKIP_DSA 0
#endif
#ifndef SKIP_MOBA
#define SKIP_MOBA 0
#endif
#ifndef P4_REPS
#define P4_REPS 1
#endif
#ifndef P0_REPS
#define P0_REPS 1
#endif
#ifndef P1_REPS
#define P1_REPS 1
#endif
#ifndef P3_REPS
#define P3_REPS 1
#endif
#ifndef P5_REPS
#define P5_REPS 1
#endif
#define P_W1C ((bf16*)(ws + WS_W1C))
#define P_W1D ((bf16*)(ws + WS_W1D))
#define P_WIN ((bf16*)(ws + WS_WIN))
#define P_WUA ((bf16*)(ws + WS_WUA))
#define P_WUB ((bf16*)(ws + WS_WUB))
#define P_WO ((bf16*)(ws + WS_WO))
#define P_W2C ((bf16*)(ws + WS_W2C))
#define P_W2D ((bf16*)(ws + WS_W2D))
#define P_XB ((bf16*)(ws + WS_XB))
#define P_HB ((bf16*)(ws + WS_H))
#define P_QA ((bf16*)(ws + WS_QA))
#define P_QB ((bf16*)(ws + WS_QB))
#define P_YA ((bf16*)(ws + WS_YA))
#define P_YB ((bf16*)(ws + WS_YB))
#define P_SIGA ((bf16*)(ws + WS_SIGA))
#define P_SIGB ((bf16*)(ws + WS_SIGB))
#define P_MG ((bf16*)(ws + WS_MG))
#define P_SSQ0 ((float*)(ws + CB_SSQ0))
#define P_SSQ1 ((float*)(ws + CB_SSQ1))
#define P_SSQ2 ((float*)(ws + CB_SSQ2))
#define P_SSQ3 ((float*)(ws + CB_SSQ3))
#define P_KSUM ((float*)(ws + CB_KSUM))
__global__ void __launch_bounds__(NWAVES * 64, 2) fwd_megakernel(Args args) {
    extern __shared__ __attribute__((aligned(16))) unsigned char lds_raw[];
    LAS unsigned char* lds = (LAS unsigned char*)lds_raw;
    volatile LAS unsigned* MISC = (volatile LAS unsigned*)(lds + MISC_OFF);
    const int tid = threadIdx.x, lane = tid & 63, wave = __builtin_amdgcn_readfirstlane(tid >> 6);
    const int G = gridDim.x, bx = blockIdx.x;
    unsigned char* const ws = args.ws;
    gu32* ctl = (gu32*)(ws + WS_CTL);
    const float* x_in = args.in[0];
    float* out = args.out;
    for (int u = tid; u < (LDS_BYTES - LDSCTL_OFF) / 4; u += NWAVES * 64) ((LAS unsigned*)(lds + LDSCTL_OFF))[u] = 0u;
    __syncthreads();
    XcdBarrier bar = xcd_barrier_post((unsigned*)(ctl + CW_BAR), MISC + 8);
#define GRID_BAR() xcd_barrier(bar)

    for (int rep0 = 0; rep0 < P0_REPS; ++rep0) {
        if (rep0) GRID_BAR();
        LAS float* scr = (LAS float*)(lds + RING_OFF + wave * 16384);
        const int gw = bx * NWAVES + wave, NGW = G * NWAVES;
        constexpr int I_FU = (D / 64) * (FF / 64), I_FD = (FF / 64) * (D / 64), I_IN = (D / 64) * (NIN / 64), I_UA = (256 / 64) * (D / 64), I_UB = (512 / 64) * (D / 64), I_WO = (D / 64) * (D / 64);
        constexpr int NITEMS = 6 * I_FU + I_IN + I_UA + I_UB + I_WO;
        static_assert(I_FU == I_FD, "items");
        for (int it = gw; it < NITEMS; it += NGW) {
            int r = it;
            if (r < 4 * I_FU) { const int mat = r / I_FU; r -= mat * I_FU; const int nblk = FF / 64, kb = r / nblk, nb = r % nblk, n0 = 64 * nb;
                const float* W = mat == 0 ? args.in[2] : mat == 1 ? args.in[3] : mat == 2 ? args.in[11] : args.in[12]; const float* gain = mat < 2 ? args.in[1] : args.in[10];
                const int orow = 256 * (n0 >> 7) + (n0 & 127) + ((mat & 1) ? 128 : 0);
                tr_item(W, D, FF, mat < 2 ? P_W1C : P_W2C, orow, 64 * kb, n0, gain, 1.0f, scr, lane); continue; }
            r -= 4 * I_FU;
            if (r < 2 * I_FD) { const int mat = r / I_FD; r -= mat * I_FD; const int nblk = D / 64, kb = r / nblk, nb = r % nblk;
                tr_item(mat == 0 ? args.in[4] : args.in[13], FF, D, mat == 0 ? P_W1D : P_W2D, 64 * nb, 64 * kb, 64 * nb, nullptr, 1.0f, scr, lane); continue; }
            r -= 2 * I_FD;
            if (r < I_IN) { const int nblk = NIN / 64, kb = r / nblk, nb = r % nblk, n0 = 64 * nb; const bool isq = (n0 < 768) || (n0 >= 2304 && n0 < 2816);
                tr_item(args.in[6], D, NIN, P_WIN, n0, 64 * kb, n0, args.in[5], isq ? QSCALE : 1.0f, scr, lane); continue; }
            r -= I_IN;
            if (r < I_UA) { const int nblk = D / 64, kb = r / nblk, nb = r % nblk; tr_item(args.in[7], 256, D, P_WUA, 64 * nb, 64 * kb, 64 * nb, nullptr, 1.0f, scr, lane); continue; }
            r -= I_UA;
            if (r < I_UB) { const int nblk = D / 64, kb = r / nblk, nb = r % nblk; tr_item(args.in[8], 512, D, P_WUB, 64 * nb, 64 * kb, 64 * nb, nullptr, 1.0f, scr, lane); continue; }
            r -= I_UB;
            { const int nblk = D / 64, kb = r / nblk, nb = r % nblk; tr_item(args.in[9], D, D, P_WO, 64 * nb, 64 * kb, 64 * nb, nullptr, 1.0f, scr, lane); }
        }
        for (int m = 2 * gw; m < M; m += 2 * NGW) {
            const GAS f32x4* xr = (const GAS f32x4*)(x_in + (size_t)m * D) + lane; f32x4 v[8]; float s0 = 0.f, s1 = 0.f;
#pragma unroll
            for (int j = 0; j < 8; ++j) v[j] = xr[64 * j];
#pragma unroll
            for (int j = 0; j < 4; ++j) { s0 += (v[j].x * v[j].x + v[j].y * v[j].y) + (v[j].z * v[j].z + v[j].w * v[j].w); s1 += (v[4 + j].x * v[4 + j].x + v[4 + j].y * v[4 + j].y) + (v[4 + j].z * v[4 + j].z + v[4 + j].w * v[4 + j].w); }
            s0 = wave_sum(s0); s1 = wave_sum(s1);
            GAS unsigned long long* o8 = (GAS unsigned long long*)(P_XB + (size_t)m * D) + lane;
#pragma unroll
            for (int j = 0; j < 8; ++j) o8[64 * j] = (unsigned long long)pk2(v[j].x, v[j].y) | ((unsigned long long)pk2(v[j].z, v[j].w) << 32);
            if (lane == 0) { P_SSQ0[m] = s0; P_SSQ0[m + 1] = s1; }
        }
    }
    GRID_BAR();

    for (int rep1 = 0; rep1 < P1_REPS; ++rep1) {
        if (rep1) GRID_BAR();
        pg8::Gemm g{P_XB, P_W1C, M, 2 * FF, D}; pg8::StaticOrder S; S.init(M, 2 * FF, G, bx);
        pg8::EpiSwiGLU E{P_HB, FF, P_SSQ0};
        pg8::gemm_phase<pg8::EpiSwiGLU, pg8::StaticOrder, true, true>(lds + RING_OFF, g, S, E);
    }
    GRID_BAR();
    {
        pg8::Gemm g{P_HB, P_W1D, M, D, FF}; pg8::StaticOrder S; S.init(M, D, G, bx);
        pg8::EpiResid<true> E{x_in, out, P_XB, P_SSQ1, 0.5f, D};
        pg8::gemm_phase<pg8::EpiResid<true>, pg8::StaticOrder, true, true>(lds + RING_OFF, g, S, E);
    }
    GRID_BAR();
#if !SKIP_MIXER
    for (int rep3 = 0; rep3 < P3_REPS; ++rep3) {
        if (rep3) GRID_BAR();
        pg8::Gemm g{P_XB, P_WIN, M, NQKV, D}; pg8::StaticOrder S; S.init(M, NQKV, G, bx);
        pg8::EpiQKV E{P_QA, P_QB, P_SSQ1, P_KSUM, M};
        pg8::gemm_phase<pg8::EpiQKV, pg8::StaticOrder, true, true>(lds + RING_OFF, g, S, E);
    }
    GRID_BAR();
    for (int p4rep = 0; p4rep < P4_REPS; ++p4rep) {
        if (p4rep) GRID_BAR();
        Scr sc; sc.O012 = (bf16*)(ws + WS_SCR + (size_t)bx * SCR_STRIDE); sc.L012 = (float*)(ws + WS_SCR + (size_t)bx * SCR_STRIDE + SCR_LSE);
        sc.O3 = (bf16*)(ws + WS_SCR3 + (size_t)bx * SCR3_STRIDE); sc.L3 = (float*)(ws + WS_SCR3 + (size_t)bx * SCR3_STRIDE + SCR3_LSE);
        const bf16* KA = P_QA + (size_t)M * 768; const bf16* VA = KA + (size_t)M * 768; const bf16* KB = P_QB + (size_t)M * 512; const bf16* VB = KB + (size_t)M * 512;
        LAS int* ITEM = (LAS int*)(lds + AL_ITEM);
        int tid_a = threadIdx.x; asm volatile("" : "+v"(tid_a));
        constexpr int N_MOBA_BIG = 16 * 29, N_DSA = 256, N_ITEMS = 512 + 256;
        for (;;) {
            if (tid == 0) ITEM[0] = (int)__hip_atomic_fetch_add(ctl + CW_QUEUE + 64 * p4rep, 1u, RLX_AGENT);
            __syncthreads();
            const int it = ITEM[0];
            __syncthreads();
            if (it >= N_ITEMS) break;
            int kind, pa, pb, pc;
            if (it < N_MOBA_BIG) { kind = 1; pc = 31 - it / 16; pa = (it % 16) >> 3; pb = it & 7; }
            else if (it < N_MOBA_BIG + N_DSA) { const int d = it - N_MOBA_BIG; kind = 0; pa = d >> 7; pb = (d >> 5) & 3; pc = d & 31; }
            else { const int r = it - N_MOBA_BIG - N_DSA; kind = 1; pc = 2 - r / 16; pa = (r % 16) >> 3; pb = r & 7; }
            if (kind) {
#if !SKIP_MOBA
                moba_unit(pa, pb, pc, P_QB, KB, VB, P_KSUM, P_YB, sc, lds, tid_a, p4rep == 0);
#endif
            } else {
#if !SKIP_DSA
                dsa_unit(pa, pb, pc, P_QA, KA, VA, P_YA, sc, lds, tid_a, p4rep == 0);
#endif
            }
        }
#if SKIP_DSA
        for (size_t i = (size_t)bx * 512 + tid; i < (size_t)M * 256 / 8; i += (size_t)G * 512) ((v4u*)P_YA)[i] = (v4u){0u, 0u, 0u, 0u};
#endif
#if SKIP_MOBA
        for (size_t i = (size_t)bx * 512 + tid; i < (size_t)M * 512 / 8; i += (size_t)G * 512) ((v4u*)P_YB)[i] = (v4u){0u, 0u, 0u, 0u};
#endif
    }
    GRID_BAR();
    for (int rep5 = 0; rep5 < P5_REPS; ++rep5) {
        if (rep5) GRID_BAR();
        pg8::StaticOrder S; S.init(M, D, G, bx);
        { pg8::Gemm g{P_XB, P_WIN + (size_t)NQKV * D, M, D, D}; pg8::EpiSig E{P_SIGA, D, P_SSQ1}; pg8::gemm_phase<pg8::EpiSig, pg8::StaticOrder, true, true>(lds + RING_OFF, g, S, E); }
        { pg8::Gemm g{P_XB, P_WIN + (size_t)(NQKV + D) * D, M, D, D}; pg8::EpiSig E{P_SIGB, D, P_SSQ1}; pg8::gemm_phase<pg8::EpiSig, pg8::StaticOrder, true, true>(lds + RING_OFF, g, S, E); }
        { pg8::Gemm g{P_YA, P_WUA, M, D, 256}; pg8::EpiGate<false> E{P_SIGA, P_MG, D}; pg8::gemm_phase<pg8::EpiGate<false>, pg8::StaticOrder, true, true>(lds + RING_OFF, g, S, E); }
        { pg8::Gemm g{P_YB, P_WUB, M, D, 512}; pg8::EpiGate<true> E{P_SIGB, P_MG, D}; pg8::gemm_phase<pg8::EpiGate<true>, pg8::StaticOrder, true, true>(lds + RING_OFF, g, S, E); }
    }
    GRID_BAR();
    {
        pg8::Gemm g{P_MG, P_WO, M, D, D}; pg8::StaticOrder S; S.init(M, D, G, bx);
        pg8::EpiResid<true> E{out, out, P_XB, P_SSQ2, 1.0f, D};
        pg8::gemm_phase<pg8::EpiResid<true>, pg8::StaticOrder, true, true>(lds + RING_OFF, g, S, E);
    }
    GRID_BAR();
    const float* SSQ_F2 = P_SSQ2;
#else
    const float* SSQ_F2 = P_SSQ1;
#endif
    {
        pg8::Gemm g{P_XB, P_W2C, M, 2 * FF, D}; pg8::StaticOrder S; S.init(M, 2 * FF, G, bx);
        pg8::EpiSwiGLU E{P_HB, FF, SSQ_F2};
        pg8::gemm_phase<pg8::EpiSwiGLU, pg8::StaticOrder, true, true>(lds + RING_OFF, g, S, E);
    }
    GRID_BAR();
    {
        pg8::Gemm g{P_HB, P_W2D, M, D, FF}; pg8::StaticOrder S; S.init(M, D, G, bx);
        pg8::EpiResid<false> E{out, out, nullptr, P_SSQ3, 0.5f, D};
        pg8::gemm_phase<pg8::EpiResid<false>, pg8::StaticOrder, true, true>(lds + RING_OFF, g, S, E);
    }
    GRID_BAR();
    {
        const int gw = bx * NWAVES + wave, NGW = G * NWAVES; const float* gf = args.in[14];
        const unsigned bad = __hip_atomic_load(ctl + CW_BAR + XB_TMO, RLX_AGENT);
        f32x4 gv[4];
#pragma unroll
        for (int j = 0; j < 4; ++j) gv[j] = ((const GAS f32x4*)gf)[lane + 64 * j];
        for (int m = gw; m < M; m += NGW) {
            GAS f32x4* xr = (GAS f32x4*)(out + (size_t)m * D) + lane; float r = __builtin_amdgcn_rsqf(P_SSQ3[m] * (1.0f / 1024.0f) + 1e-6f);
            if (bad) r = __builtin_nanf("");
#pragma unroll
            for (int j = 0; j < 4; ++j) { const f32x4 v = xr[64 * j]; xr[64 * j] = v * r * gv[j]; }
        }
    }
}

extern "C" void kernel_launch(void* const* d_in, const int* in_sizes, int n_in, void* d_out, int out_size, void* d_ws, size_t ws_size, hipStream_t stream) {
    static int grid = 0;
    if (grid == 0) {
        if (n_in != 15 || in_sizes[0] != M * D || out_size != M * D || ws_size < WS_END) { fprintf(stderr, "kernel_launch: unexpected shapes (n_in %d, in0 %d, out %d, ws %zu)\n", n_in, n_in > 0 ? in_sizes[0] : -1, out_size, ws_size); grid = -1; return; }
        int dev = 0, cus = 0, per_cu = 0;
        if (hipGetDevice(&dev) != hipSuccess || hipDeviceGetAttribute(&cus, hipDeviceAttributeMultiprocessorCount, dev) != hipSuccess) { grid = -1; return; }
        if (hipFuncSetAttribute((const void*)fwd_megakernel, hipFuncAttributeMaxDynamicSharedMemorySize, LDS_BYTES) != hipSuccess) { fprintf(stderr, "kernel_launch: hipFuncSetAttribute failed\n"); grid = -1; return; }
        if (hipOccupancyMaxActiveBlocksPerMultiprocessor(&per_cu, (const void*)fwd_megakernel, NWAVES * 64, LDS_BYTES) != hipSuccess || per_cu < 1)
            fprintf(stderr, "kernel_launch: note: occupancy query reports %d workgroups per CU\n", per_cu);
        (void)hipGetLastError();
        grid = cus > 256 ? 256 : cus;
    }
    if (grid < 0) return;
    if (hipMemsetAsync((char*)d_ws + WS_CTL, 0, CTL_ZERO_BYTES, stream) != hipSuccess) { fprintf(stderr, "kernel_launch: memset failed\n"); return; }
    Args a{};
    for (int i = 0; i < 15; ++i) a.in[i] = (const float*)d_in[i];
    a.out = (float*)d_out; a.ws = (unsigned char*)d_ws;
    hipLaunchKernelGGL(fwd_megakernel, dim3(grid), dim3(NWAVES * 64), LDS_BYTES, stream, a);
}
```

```cpp
#include <hip/hip_runtime.h>
#include <cstdio>
#include <cstdint>
#include <cmath>
namespace pg8 {
#define PG8_LAS __attribute__((address_space(3)))
typedef unsigned short bf16_t;
typedef short bf16x8 __attribute__((ext_vector_type(8)));
typedef float f32x4 __attribute__((ext_vector_type(4)));
typedef unsigned u32x4 __attribute__((ext_vector_type(4)));
constexpr int BM = 256, BK = 64, HALF = 128, HTB = HALF * BK * 2  , STAGE_BYTES = 8 * HTB, NXCD = 8, WGM = 8;

__host__ __device__ __forceinline__ int lds_byte(int r, int c) { const int st = (r >> 4) * 2 + (c >> 5), rr = r & 15, cc = c & 31, ob = rr * 64 + cc * 2; return st * 1024 + (ob ^ (((ob >> 9) & 1) << 5)); }
__host__ __device__ __forceinline__ void stage_rc(int b, int& R, int& C) { const int st = b / 1024, sb = b % 1024, swz = sb ^ (((sb >> 9) & 1) << 5); R = (st >> 1) * 16 + swz / 64; C = (st & 1) * 32 + (swz % 64) / 2; }
__host__ __device__ __forceinline__ int perm32(int rho) { const int n = rho >> 4, i = rho & 15; return 8 * (i >> 2) + 4 * n + (i & 3); }

struct Unit { int pm, pn; };
struct Gemm { const bf16_t* A; const bf16_t* Bt; int M, N, K; };

struct StaticOrder {
    int nM, nN, nwg, G, c;
    __host__ __device__ void init(int M, int N, int G_, int c_) { nM = M / BM; nN = N / BM; nwg = nM * nN; G = G_; c = c_; }
    __host__ __device__ bool next(int i, Unit& u) const {
        const long L = (long)i * G + c; if (L >= nwg) return false;
        int wgid = (int)L; { const int q = nwg / NXCD, r = nwg % NXCD, xcd = wgid % NXCD, off = wgid / NXCD; wgid = (xcd < r ? xcd * (q + 1) : r * (q + 1) + (xcd - r) * q) + off; }
        const int nig = WGM * nN, gid = wgid / nig, fm = gid * WGM, gsz = (nM - fm) < WGM ? (nM - fm) : WGM;
        u.pm = fm + ((wgid % nig) % gsz); u.pn = (wgid % nig) / gsz; return true;
    }
    __device__ __forceinline__ void a_ready(const Unit&) const {}
    __device__ __forceinline__ void done(const Unit&) const {}
};

__device__ __forceinline__ unsigned cvt_pk_bf16(float lo, float hi) { unsigned r; asm volatile("v_cvt_pk_bf16_f32 %0, %1, %2" : "=v"(r) : "v"(lo), "v"(hi)); return r; }
typedef float f32x2 __attribute__((ext_vector_type(2)));

typedef unsigned u32x2 __attribute__((ext_vector_type(2)));
__device__ __forceinline__ float row_rstd(const float* ssq, int row) { return __builtin_amdgcn_rsqf(ssq[row] * (1.0f / 1024.0f) + 1e-6f); }
__device__ __forceinline__ float bf_lo(unsigned w) { return __uint_as_float(w << 16); }
__device__ __forceinline__ float bf_hi(unsigned w) { return __uint_as_float(w & 0xffff0000u); }
__device__ __forceinline__ float sigmoid_f(float z) { return __builtin_amdgcn_rcpf(1.0f + __builtin_amdgcn_exp2f(-1.4426950408889634f * z)); }

struct EpiSwiGLU {
    static constexpr bool PERM = true, AFTER_DRAIN = false;
    bf16_t* H; int ldc; const float* ssq;
    __device__ __forceinline__ void operator()(const f32x4 (&acc)[2][2][4][2], const Unit& u, int wr, int wc, int fr, int fq) const {
        const int row0 = u.pm * BM + wr * 64 + fr, col0 = u.pn * HALF + wc * 32 + 8 * fq;
#pragma unroll
        for (int ai = 0; ai < 2; ++ai)
#pragma unroll
            for (int m = 0; m < 4; ++m) { const int row = row0 + ai * HALF + m * 16; const float r = row_rstd(ssq, row);
                float h[8];
#pragma unroll
                for (int n = 0; n < 2; ++n)
#pragma unroll
                    for (int j = 0; j < 4; ++j) { const float g = acc[ai][0][m][n][j] * r, up = acc[ai][1][m][n][j] * r; h[n * 4 + j] = g * sigmoid_f(g) * up; }
                u32x4 w; w.x = cvt_pk_bf16(h[0], h[1]); w.y = cvt_pk_bf16(h[2], h[3]); w.z = cvt_pk_bf16(h[4], h[5]); w.w = cvt_pk_bf16(h[6], h[7]);
                *(u32x4*)(H + (size_t)row * ldc + col0) = w; }
    }
};

template <bool WRITE_XB> struct EpiResid {
    static constexpr bool PERM = false, AFTER_DRAIN = false;
    const float* base; float* out; bf16_t* xb; float* ssq_out; float alpha; int ldc;
    __device__ __forceinline__ void operator()(const f32x4 (&acc)[2][2][4][2], const Unit& u, int wr, int wc, int fr, int fq) const {
        const int row0 = u.pm * BM + wr * 64 + fr, col0 = u.pn * BM + wc * 32 + 4 * fq;
#pragma unroll
        for (int ai = 0; ai < 2; ++ai)
#pragma unroll
            for (int m = 0; m < 4; ++m) { const int row = row0 + ai * HALF + m * 16; const size_t off = (size_t)row * ldc + col0; float s = 0.f;
#pragma unroll
                for (int bj = 0; bj < 2; ++bj)
#pragma unroll
                    for (int n = 0; n < 2; ++n) { const f32x4 b = *(const f32x4*)(base + off + bj * HALF + n * 16); const f32x4 v = b + acc[ai][bj][m][n] * alpha;
                        *(f32x4*)(out + off + bj * HALF + n * 16) = v; s += (v[0] * v[0] + v[1] * v[1]) + (v[2] * v[2] + v[3] * v[3]);
                        if (WRITE_XB) { u32x2 w; w.x = cvt_pk_bf16(v[0], v[1]); w.y = cvt_pk_bf16(v[2], v[3]); *(u32x2*)(xb + off + bj * HALF + n * 16) = w; } }
                s += __shfl_xor(s, 16); s += __shfl_xor(s, 32);
                if (fq == 0) __hip_atomic_fetch_add(ssq_out + row, s, __ATOMIC_RELAXED, __HIP_MEMORY_SCOPE_AGENT);
                asm volatile("" ::: "memory"); }
    }
};

struct EpiQKV {
    static constexpr bool PERM = true, AFTER_DRAIN = false;
    bf16_t* QA; bf16_t* QB; const float* ssq; float* ksum; int Mrows;
    __device__ __forceinline__ void operator()(const f32x4 (&acc)[2][2][4][2], const Unit& u, int wr, int wc, int fr, int fq) const {
        const int row0 = u.pm * BM + wr * 64 + fr; bf16_t* base; int ldc, colt;
        if (u.pn < 9) { const int reg = u.pn / 3; base = QA + (size_t)reg * Mrows * 768; ldc = 768; colt = (u.pn - reg * 3) * BM; }
        else { const int p = u.pn - 9, reg = p >> 1; base = QB + (size_t)reg * Mrows * 512; ldc = 512; colt = (p & 1) * BM; }
        const int col0 = colt + wc * 32 + 8 * fq; const bool km = (u.pn == 11) || (u.pn == 12);
        f32x4 cs[2][2];
#pragma unroll
        for (int bj = 0; bj < 2; ++bj)
#pragma unroll
            for (int n = 0; n < 2; ++n) cs[bj][n] = (f32x4){0.f, 0.f, 0.f, 0.f};
#pragma unroll
        for (int ai = 0; ai < 2; ++ai)
#pragma unroll
            for (int m = 0; m < 4; ++m) { const int row = row0 + ai * HALF + m * 16; const float r = row_rstd(ssq, row); bf16_t* rowp = base + (size_t)row * ldc + col0;
#pragma unroll
                for (int bj = 0; bj < 2; ++bj) { const f32x4 v0 = acc[ai][bj][m][0] * r, v1 = acc[ai][bj][m][1] * r; cs[bj][0] += v0; cs[bj][1] += v1;
                    u32x4 w; w.x = cvt_pk_bf16(v0[0], v0[1]); w.y = cvt_pk_bf16(v0[2], v0[3]); w.z = cvt_pk_bf16(v1[0], v1[1]); w.w = cvt_pk_bf16(v1[2], v1[3]);
                    *(u32x4*)(rowp + bj * HALF) = w; } }
        if (km) {
            const int b = u.pm >> 5, blk = u.pm & 31;
#pragma unroll
            for (int bj = 0; bj < 2; ++bj)
#pragma unroll
                for (int n = 0; n < 2; ++n)
#pragma unroll
                    for (int j = 0; j < 4; ++j) { float s = cs[bj][n][j]; s += __shfl_xor(s, 1); s += __shfl_xor(s, 2); s += __shfl_xor(s, 4); s += __shfl_xor(s, 8);
                        if (fr == 0) { const int c = (u.pn - 11) * BM + bj * HALF + wc * 32 + 8 * fq + 4 * n + j; const int head = c >> 6, d = c & 63;
                            __hip_atomic_fetch_add(ksum + ((size_t)((b * 8 + head) * 32 + blk)) * 64 + d, s, __ATOMIC_RELAXED, __HIP_MEMORY_SCOPE_AGENT); } }
        }
    }
};

struct EpiSig {
    static constexpr bool PERM = true, AFTER_DRAIN = false;
    bf16_t* O; int ldc; const float* ssq;
    __device__ __forceinline__ void operator()(const f32x4 (&acc)[2][2][4][2], const Unit& u, int wr, int wc, int fr, int fq) const {
        const int row0 = u.pm * BM + wr * 64 + fr, col0 = u.pn * BM + wc * 32 + 8 * fq;
#pragma unroll
        for (int ai = 0; ai < 2; ++ai)
#pragma unroll
            for (int m = 0; m < 4; ++m) { const int row = row0 + ai * HALF + m * 16; const float r = row_rstd(ssq, row); bf16_t* rowp = O + (size_t)row * ldc + col0;
#pragma unroll
                for (int bj = 0; bj < 2; ++bj) { f32x4 v0 = acc[ai][bj][m][0] * r, v1 = acc[ai][bj][m][1] * r;
#pragma unroll
                    for (int j = 0; j < 4; ++j) { v0[j] = sigmoid_f(v0[j]); v1[j] = sigmoid_f(v1[j]); }
                    u32x4 w; w.x = cvt_pk_bf16(v0[0], v0[1]); w.y = cvt_pk_bf16(v0[2], v0[3]); w.z = cvt_pk_bf16(v1[0], v1[1]); w.w = cvt_pk_bf16(v1[2], v1[3]);
                    *(u32x4*)(rowp + bj * HALF) = w; } }
    }
};

template <bool ADD> struct EpiGate {
    static constexpr bool PERM = true, AFTER_DRAIN = false;
    const bf16_t* SIG; bf16_t* O; int ldc;
    __device__ __forceinline__ void operator()(const f32x4 (&acc)[2][2][4][2], const Unit& u, int wr, int wc, int fr, int fq) const {
        const int row0 = u.pm * BM + wr * 64 + fr, col0 = u.pn * BM + wc * 32 + 8 * fq;
#pragma unroll
        for (int ai = 0; ai < 2; ++ai)
#pragma unroll
            for (int m = 0; m < 4; ++m) { const size_t off = (size_t)(row0 + ai * HALF + m * 16) * ldc + col0;
#pragma unroll
                for (int bj = 0; bj < 2; ++bj) { const u32x4 sg = *(const u32x4*)(SIG + off + bj * HALF); f32x4 v0 = acc[ai][bj][m][0], v1 = acc[ai][bj][m][1];
                    v0[0] *= bf_lo(sg.x); v0[1] *= bf_hi(sg.x); v0[2] *= bf_lo(sg.y); v0[3] *= bf_hi(sg.y); v1[0] *= bf_lo(sg.z); v1[1] *= bf_hi(sg.z); v1[2] *= bf_lo(sg.w); v1[3] *= bf_hi(sg.w);
                    if (ADD) { const u32x4 pv = *(const u32x4*)(O + off + bj * HALF);
                        v0[0] += bf_lo(pv.x); v0[1] += bf_hi(pv.x); v0[2] += bf_lo(pv.y); v0[3] += bf_hi(pv.y); v1[0] += bf_lo(pv.z); v1[1] += bf_hi(pv.z); v1[2] += bf_lo(pv.w); v1[3] += bf_hi(pv.w); }
                    u32x4 w; w.x = cvt_pk_bf16(v0[0], v0[1]); w.y = cvt_pk_bf16(v0[2], v0[3]); w.z = cvt_pk_bf16(v1[0], v1[1]); w.w = cvt_pk_bf16(v1[2], v1[3]);
                    *(u32x4*)(O + off + bj * HALF) = w; }
                asm volatile("" ::: "memory"); }
    }
};

template <class Epi, class Sched, bool ALIGN_EPI = false, bool SP2 = false>
__device__ __forceinline__ void gemm_phase(PG8_LAS unsigned char* lds, const Gemm g, const Sched& S, const Epi& E) {
    int tid_ = threadIdx.x; asm volatile("" : "+v"(tid_));
    const int tid = tid_, wid = __builtin_amdgcn_readfirstlane(tid >> 6), lane = tid & 63, wr = wid >> 2, wc = wid & 3, fr = lane & 15, fq = lane >> 4;
    int K = g.K; asm volatile("" : "+s"(K)); const int nt = K / BK;
    unsigned voffA[2], voffB[2];
#pragma unroll
    for (int i = 0; i < 2; ++i) { int R, C; stage_rc(tid * 16 + i * 8192, R, C); const int Rb = Epi::PERM ? ((R & ~31) + perm32(R & 31)) : R;
        voffA[i] = (unsigned)(R * K + C) * 2u; voffB[i] = (unsigned)(Rb * K + C) * 2u; }
    const size_t kstep = (size_t)(BK * 2);
    const size_t hstep = (size_t)HALF * K * 2;
    const size_t tstep = 2 * hstep;
    const unsigned ldsw = (unsigned)wid * 1024u;
    const int aoff = lds_byte(wr * 64 + fr, fq * 8), boff = lds_byte(wc * 32 + fr, fq * 8);
#define PG8_SA(b, h) (((b) * 2 + (h)) * HTB)
#define PG8_SB(b, h) ((4 + (b) * 2 + (h)) * HTB)
#define PG8_STAGE(bufoff, gbase, voff) do { _Pragma("unroll") for (int _i = 0; _i < 2; ++_i) \
        __builtin_amdgcn_global_load_lds((const unsigned*)((const char*)(gbase) + (voff)[_i]), (PG8_LAS unsigned*)(lds + (bufoff) + ldsw + _i * 8192), 16, 0, 0); } while (0)
#define PG8_LDA(dst, b, h) do { _Pragma("unroll") for (int m = 0; m < 4; ++m) _Pragma("unroll") for (int k = 0; k < 2; ++k) dst[m][k] = *(const PG8_LAS bf16x8*)(lds + PG8_SA(b, h) + aoff + m * 2048 + k * 1024); } while (0)
#define PG8_LDB(dst, b, h) do { _Pragma("unroll") for (int n = 0; n < 2; ++n) _Pragma("unroll") for (int k = 0; k < 2; ++k) dst[n][k] = *(const PG8_LAS bf16x8*)(lds + PG8_SB(b, h) + boff + n * 2048 + k * 1024); } while (0)
#define PG8_MMA(ai, bj, At, Bt) do { __builtin_amdgcn_s_setprio(1); _Pragma("unroll") for (int m = 0; m < 4; ++m) _Pragma("unroll") for (int n = 0; n < 2; ++n) _Pragma("unroll") for (int k = 0; k < 2; ++k) \
        acc[ai][bj][m][n] = __builtin_amdgcn_mfma_f32_16x16x32_bf16(Bt[n][k], At[m][k], acc[ai][bj][m][n], 0, 0, 0); __builtin_amdgcn_s_setprio(0); } while (0)
#define PG8_WAIT_V(n) asm volatile("s_waitcnt vmcnt(" #n ")" ::: "memory")
#define PG8_WAIT_L(n) asm volatile("s_waitcnt lgkmcnt(" #n ")" ::: "memory")
#define PG8_BAR __builtin_amdgcn_s_barrier()
#define PG8_SCHED __builtin_amdgcn_sched_barrier(0)
    Unit cur, nxt; int ui = 0;
    if (!S.next(0, cur)) return;
    f32x4 acc[2][2][4][2];
#pragma unroll
    for (int a = 0; a < 2; ++a)
#pragma unroll
        for (int b = 0; b < 2; ++b)
#pragma unroll
            for (int m = 0; m < 4; ++m)
#pragma unroll
                for (int n = 0; n < 2; ++n) acc[a][b][m][n] = (f32x4){0.f, 0.f, 0.f, 0.f};
    bf16x8 At[4][2], B0[2][2], B1[2][2];
    const char* cA = (const char*)g.A + (size_t)cur.pm * tstep; const char* cB = (const char*)g.Bt + (size_t)cur.pn * tstep;
    S.a_ready(cur);
    if constexpr (SP2) {
        PG8_STAGE(PG8_SB(0, 0), cB, voffB); PG8_STAGE(PG8_SB(0, 1), cB + hstep, voffB); PG8_STAGE(PG8_SA(0, 0), cA, voffA); PG8_STAGE(PG8_SA(0, 1), cA + hstep, voffA);
        if (wr == 1) PG8_BAR;
        PG8_WAIT_V(2); PG8_BAR;
        PG8_STAGE(PG8_SB(1, 0), cB + kstep, voffB); PG8_STAGE(PG8_SA(1, 0), cA + kstep, voffA); PG8_STAGE(PG8_SB(1, 1), cB + hstep + kstep, voffB);
        PG8_WAIT_V(6); PG8_BAR;
    } else {
        PG8_STAGE(PG8_SB(0, 0), cB, voffB); PG8_STAGE(PG8_SA(0, 0), cA, voffA); PG8_STAGE(PG8_SB(0, 1), cB + hstep, voffB); PG8_STAGE(PG8_SA(0, 1), cA + hstep, voffA);
        if (wr == 1) PG8_BAR;
        PG8_WAIT_V(4); PG8_BAR;
        PG8_STAGE(PG8_SB(1, 0), cB + kstep, voffB); PG8_STAGE(PG8_SA(1, 0), cA + kstep, voffA); PG8_STAGE(PG8_SB(1, 1), cB + hstep + kstep, voffB);
        PG8_WAIT_V(6); PG8_BAR;
    }
    for (;;) {
        const bool has_next = S.next(ui + 1, nxt);
        const char* nA = has_next ? (const char*)g.A + (size_t)nxt.pm * tstep : cA; const char* nB = has_next ? (const char*)g.Bt + (size_t)nxt.pn * tstep : cB;
        for (int t = 0; t < nt; t += 2) {
            const bool last = (t == nt - 2);
            const char* a1 = cA + (size_t)(t + 1) * kstep;
            const char* a2 = last ? nA : cA + (size_t)(t + 2) * kstep; const char* b2 = last ? nB : cB + (size_t)(t + 2) * kstep;
            const char* a3 = a2 + kstep; const char* b3 = b2 + kstep;
            if (last && has_next) S.a_ready(nxt);
            if constexpr (SP2) {
            PG8_LDB(B0, 0, 0); PG8_LDB(B1, 0, 1); PG8_SCHED; PG8_LDA(At, 0, 0); PG8_STAGE(PG8_SA(1, 1), a1 + hstep, voffA);
            PG8_WAIT_V(8); PG8_WAIT_L(0); PG8_BAR; PG8_MMA(0, 0, At, B0); PG8_MMA(0, 1, At, B1); PG8_BAR; PG8_SCHED;
            PG8_LDA(At, 0, 1); PG8_STAGE(PG8_SB(0, 0), b2, voffB); PG8_STAGE(PG8_SB(0, 1), b2 + hstep, voffB); PG8_STAGE(PG8_SA(0, 0), a2, voffA);
            PG8_WAIT_V(8); PG8_WAIT_L(0); PG8_BAR; PG8_MMA(1, 0, At, B0); PG8_MMA(1, 1, At, B1); PG8_BAR; PG8_SCHED;
            PG8_LDB(B0, 1, 0); PG8_LDB(B1, 1, 1); PG8_SCHED; PG8_LDA(At, 1, 0); PG8_STAGE(PG8_SA(0, 1), a2 + hstep, voffA);
            PG8_WAIT_V(8); PG8_WAIT_L(0); PG8_BAR; PG8_MMA(0, 0, At, B0); PG8_MMA(0, 1, At, B1); PG8_BAR; PG8_SCHED;
            PG8_LDA(At, 1, 1); PG8_STAGE(PG8_SB(1, 0), b3, voffB); PG8_STAGE(PG8_SB(1, 1), b3 + hstep, voffB); PG8_STAGE(PG8_SA(1, 0), a3, voffA);
            PG8_WAIT_V(8); PG8_WAIT_L(0); PG8_BAR; PG8_MMA(1, 0, At, B0); PG8_MMA(1, 1, At, B1); PG8_BAR; PG8_SCHED;
            } else {
            PG8_LDB(B0, 0, 0); PG8_SCHED; PG8_LDA(At, 0, 0); PG8_STAGE(PG8_SA(1, 1), a1 + hstep, voffA);
            PG8_WAIT_L(8); PG8_BAR; PG8_WAIT_L(0); PG8_MMA(0, 0, At, B0); PG8_BAR; PG8_SCHED;
            PG8_LDB(B1, 0, 1); PG8_STAGE(PG8_SB(0, 0), b2, voffB);
            PG8_BAR; PG8_WAIT_L(0); PG8_MMA(0, 1, At, B1); PG8_BAR;
            PG8_LDA(At, 0, 1); PG8_STAGE(PG8_SA(0, 0), a2, voffA);
            PG8_BAR; PG8_WAIT_L(0); PG8_MMA(1, 0, At, B0); PG8_BAR; PG8_SCHED;
            PG8_STAGE(PG8_SB(0, 1), b2 + hstep, voffB);
            PG8_WAIT_V(6); PG8_BAR; PG8_MMA(1, 1, At, B1); PG8_BAR;
            PG8_LDB(B0, 1, 0); PG8_SCHED; PG8_LDA(At, 1, 0); PG8_STAGE(PG8_SA(0, 1), a2 + hstep, voffA);
            PG8_WAIT_L(8); PG8_BAR; PG8_WAIT_L(0); PG8_MMA(0, 0, At, B0); PG8_BAR; PG8_SCHED;
            PG8_LDB(B1, 1, 1); PG8_STAGE(PG8_SB(1, 0), b3, voffB);
            PG8_BAR; PG8_WAIT_L(0); PG8_MMA(0, 1, At, B1); PG8_BAR;
            PG8_LDA(At, 1, 1); PG8_STAGE(PG8_SA(1, 0), a3, voffA);
            PG8_BAR; PG8_WAIT_L(0); PG8_MMA(1, 0, At, B0); PG8_BAR; PG8_SCHED;
            PG8_STAGE(PG8_SB(1, 1), b3 + hstep, voffB);
            PG8_WAIT_V(6); PG8_BAR; PG8_MMA(1, 1, At, B1); PG8_BAR;
            }
        }
        if constexpr (ALIGN_EPI) { if (wr == 0) PG8_BAR; }
        if constexpr (!Epi::AFTER_DRAIN) { E(acc, cur, wr, wc, fr, fq); S.done(cur); }
        if (!has_next) break;
#pragma unroll
        for (int a = 0; a < 2; ++a)
#pragma unroll
            for (int b = 0; b < 2; ++b)
#pragma unroll
                for (int m = 0; m < 4; ++m)
#pragma unroll
                    for (int n = 0; n < 2; ++n) acc[a][b][m][n] = (f32x4){0.f, 0.f, 0.f, 0.f};
        cur = nxt; cA = nA; cB = nB; ++ui;
        if constexpr (ALIGN_EPI) { if (wr == 1) PG8_BAR; }
    }
    PG8_WAIT_V(0);
    if constexpr (!ALIGN_EPI) { if (wr == 0) PG8_BAR; }
    PG8_BAR;
    if constexpr (Epi::AFTER_DRAIN) { E.fused(acc, cur, wr, wc, fr, fq, lds, wid, lane); S.done(cur); }
#undef PG8_SA
#undef PG8_SB
#undef PG8_STAGE
#undef PG8_LDA
#undef PG8_LDB
#undef PG8_MMA
#undef PG8_WAIT_V
#undef PG8_WAIT_L
#undef PG8_BAR
#undef PG8_SCHED
}
}
#define GAS __attribute__((address_space(1)))
#define LAS __attribute__((address_space(3)))
typedef unsigned short bf16;
typedef unsigned v4u __attribute__((ext_vector_type(4)));
typedef float f32x4 __attribute__((ext_vector_type(4)));
typedef short bf16x8 __attribute__((ext_vector_type(8)));
typedef GAS unsigned gu32;
typedef GAS unsigned long long gu64;
#define RLX_AGENT __ATOMIC_RELAXED, __HIP_MEMORY_SCOPE_AGENT
#define LDS_WAIT() asm volatile("s_waitcnt lgkmcnt(0)" ::: "memory")
#define VM_WAIT() asm volatile("s_waitcnt vmcnt(0)" ::: "memory")
__device__ __forceinline__ unsigned long long rt() { return __builtin_amdgcn_s_memrealtime(); }
__device__ __forceinline__ unsigned f2bf(float f) { unsigned u = __builtin_bit_cast(unsigned, f); return (u + 0x7fffu + ((u >> 16) & 1u)) >> 16; }
__device__ __forceinline__ unsigned pk2(float lo, float hi) { return f2bf(lo) | (f2bf(hi) << 16); }

#define XB_TMO      128
#define XB_XCNT(j)  (256  + 64 * (j))
#define XB_XSUB(j)  (1280 + 64 * (j))
#define XB_XGEN(j)  (2304 + 64 * (j))
#define XB_TOP      3328
#define XB_TOPGEN   3392
#define XCD_BAR_WORDS 3456
#define XB_SPIN_CAP (1u << 18)

__device__ __forceinline__ unsigned xb_ld(unsigned* p)              { return __hip_atomic_load(p, __ATOMIC_RELAXED, __HIP_MEMORY_SCOPE_AGENT); }
__device__ __forceinline__ unsigned xb_add(unsigned* p, unsigned v) { return __hip_atomic_fetch_add(p, v, __ATOMIC_RELAXED, __HIP_MEMORY_SCOPE_AGENT); }
__device__ __forceinline__ unsigned xb_xcc_id() { return (unsigned)__builtin_amdgcn_s_getreg((3 << 11) | 20) & 0xFu; }
#define XB_SPIN(cond, bar) do { unsigned _sp = 0; while (cond) { __builtin_amdgcn_s_sleep(1); \
    if ((++_sp & 255u) == 0u) { if (xb_ld(&(bar)[XB_TMO])) break; if (_sp > XB_SPIN_CAP) { atomicAdd(&(bar)[XB_TMO], 1u); break; } } } } while (0)

struct XcdBarrier {
    unsigned* bar; unsigned x;
    volatile LAS unsigned* st;
};

__device__ __forceinline__ XcdBarrier xcd_barrier_post(unsigned* bar, volatile LAS unsigned* st) {
    XcdBarrier b; b.bar = bar; b.x = xb_xcc_id(); b.st = st;
    if (threadIdx.x == 0) (void)xb_add(&bar[XB_XCNT(b.x)], 1u);
    return b;
}
__device__ __forceinline__ void xcd_barrier_complete(unsigned* bar, unsigned x, unsigned& nloc, unsigned& nx) {
    const unsigned G = gridDim.x * gridDim.y * gridDim.z;
    unsigned sum, cnt, mine, sp = 0u;
    for (;;) {
        sum = 0u; cnt = 0u; mine = 0u;
#pragma unroll
        for (unsigned j = 0; j < 16; ++j) { const unsigned c = xb_ld(&bar[XB_XCNT(j)]); sum += c; cnt += (c > 0u) ? 1u : 0u; mine = (j == x) ? c : mine; }
        if (sum == G) break;
        __builtin_amdgcn_s_sleep(1);
        if ((++sp & 255u) == 0u) { if (xb_ld(&bar[XB_TMO])) break; if (sp > XB_SPIN_CAP) { atomicAdd(&bar[XB_TMO], 1u); break; } }
    }
    nloc = mine > 0u ? mine : 1u; nx = cnt > 0u ? cnt : 1u;
}

__device__ __forceinline__ void xcd_barrier(const XcdBarrier& b) {
    asm volatile("s_waitcnt vmcnt(0)" ::: "memory");
    __syncthreads();
    if (threadIdx.x == 0) {
        unsigned* bar = b.bar;
        __builtin_amdgcn_s_waitcnt(0);
        unsigned nloc = b.st[0], nx = b.st[1];
        if (nloc == 0u) { xcd_barrier_complete(bar, b.x, nloc, nx); b.st[0] = nloc; b.st[1] = nx; }
        const unsigned old = xb_add(&bar[XB_XSUB(b.x)], 1u);
        const unsigned gen = old / nloc;
        if (old + 1u == (gen + 1u) * nloc) {
            __builtin_amdgcn_fence(__ATOMIC_RELEASE, "agent");
            asm volatile("s_waitcnt vmcnt(0)" ::: "memory");
            const unsigned og = xb_add(&bar[XB_TOP], 1u);
            const unsigned tg = og / nx;
            if (og + 1u == (tg + 1u) * nx) xb_add(&bar[XB_TOPGEN], 1u);
            else XB_SPIN(xb_ld(&bar[XB_TOPGEN]) == tg, bar);
            __builtin_amdgcn_fence(__ATOMIC_ACQUIRE, "agent");
            xb_add(&bar[XB_XGEN(b.x)], 1u);
            asm volatile("s_waitcnt vmcnt(0)" ::: "memory");
        } else {
            XB_SPIN(xb_ld(&bar[XB_XGEN(b.x)]) == gen, bar);
            __builtin_amdgcn_fence(__ATOMIC_ACQUIRE, "agent");
            asm volatile("s_waitcnt vmcnt(0)" ::: "memory");
        }
    }
    __syncthreads();
}

namespace att {
typedef short bf16x8 __attribute__((ext_vector_type(8)));
typedef short s16x4 __attribute__((ext_vector_type(4)));
typedef float f32x16 __attribute__((ext_vector_type(16)));
typedef unsigned u32x4 __attribute__((ext_vector_type(4)));
typedef short v4i16_t __attribute__((ext_vector_type(4)));
typedef float f32x2_t __attribute__((ext_vector_type(2)));
typedef __bf16 bf16x2_t __attribute__((ext_vector_type(2)));
typedef unsigned short bfraw;
#define ALAS __attribute__((address_space(3)))
__device__ __forceinline__ int crow(int r, int hi) { return (r & 3) + 8 * (r >> 2) + 4 * hi; }
__device__ __forceinline__ unsigned cvtpk(float lo, float hi) { f32x2_t v = {lo, hi}; bf16x2_t b = __builtin_convertvector(v, bf16x2_t); return __builtin_bit_cast(unsigned, b); }
__device__ __forceinline__ float swapmax(float v) { auto rr = __builtin_amdgcn_permlane32_swap(__float_as_uint(v), __float_as_uint(v), false, false); return fmaxf(__uint_as_float(rr[0]), __uint_as_float(rr[1])); }
__device__ __forceinline__ float swapsum(float v) { auto rr = __builtin_amdgcn_permlane32_swap(__float_as_uint(v), __float_as_uint(v), false, false); return __uint_as_float(rr[0]) + __uint_as_float(rr[1]); }
__device__ __forceinline__ s16x4 vtr(ALAS const unsigned char* p) { return __builtin_bit_cast(s16x4, __builtin_amdgcn_ds_read_tr16_b64_v4i16((ALAS v4i16_t*)p)); }
__device__ __forceinline__ int clampi(int v, int lo, int hi) { return v < lo ? lo : (v > hi ? hi : v); }

#define ATT_THR 6.0f
__device__ __forceinline__ void chunk_softmax_pv(f32x16& p0, float dqf, float ns2, int MASK, bool NEGK, float kf0, ALAS const unsigned char* vbl, f32x16& o0, f32x16& o1, float& m, float& l, ALAS float* wsf, int r32, int hi) {
    if (MASK == 1) {
#pragma unroll
        for (int r = 0; r < 16; ++r) { const float t = dqf - (float)((r & 3) + 8 * (r >> 2)); p0[r] = fmaf(fminf(t, 0.f), 1e30f, fmaf(ns2, t, p0[r])); }
    } else if (MASK == 2) {
#pragma unroll
        for (int r = 0; r < 16; ++r) { const float t = dqf - (float)((r & 3) + 8 * (r >> 2)); const float u = t - __builtin_amdgcn_fmed3f(t, 0.f, 128.f); p0[r] = fmaf(-fabsf(u), 1e30f, fmaf(ns2, t, p0[r])); }
    } else {
#pragma unroll
        for (int r = 0; r < 16; ++r) { const float t = dqf - (float)((r & 3) + 8 * (r >> 2)); p0[r] = fmaf(ns2, t, p0[r]); }
    }
    if (NEGK) {
#pragma unroll
        for (int r = 0; r < 16; ++r) { const float kk = kf0 + (float)((r & 3) + 8 * (r >> 2)); p0[r] = fmaf(fminf(kk, 0.f), 1e30f, p0[r]); }
    }
    float mx = p0[0];
#pragma unroll
    for (int r = 1; r < 16; ++r) mx = fmaxf(mx, p0[r]);
    mx = swapmax(mx);
    float mu = (m == -INFINITY) ? 0.f : m;
    if (__any(mx > m + ATT_THR)) {
        const float mn = fmaxf(m, mx); mu = (mn == -INFINITY) ? 0.f : mn;
        const float alpha = __builtin_amdgcn_exp2f(m - mu);
        m = mn; l *= alpha;
        if (hi == 0) wsf[r32] = alpha;
#pragma unroll
        for (int r = 0; r < 16; ++r) { const float a = wsf[crow(r, hi)]; o0[r] *= a; o1[r] *= a; }
    }
    float ls = 0.f;
#pragma unroll
    for (int r = 0; r < 16; ++r) { p0[r] = __builtin_amdgcn_exp2f(p0[r] - mu); ls += p0[r]; }
    l += ls;
    u32x4 pw[2];
#pragma unroll
    for (int s = 0; s < 2; ++s) pw[s] = (u32x4){cvtpk(p0[8 * s], p0[8 * s + 1]), cvtpk(p0[8 * s + 2], p0[8 * s + 3]), cvtpk(p0[8 * s + 4], p0[8 * s + 5]), cvtpk(p0[8 * s + 6], p0[8 * s + 7])};
#pragma unroll
    for (int s = 0; s < 2; ++s) {
        const s16x4 a0 = vtr(vbl + s * 1024), a1 = vtr(vbl + s * 1024 + 512), b0v = vtr(vbl + 2048 + s * 1024), b1v = vtr(vbl + 2048 + s * 1024 + 512);
        const bf16x8 v0 = (bf16x8){a0[0], a0[1], a0[2], a0[3], a1[0], a1[1], a1[2], a1[3]}, v1 = (bf16x8){b0v[0], b0v[1], b0v[2], b0v[3], b1v[0], b1v[1], b1v[2], b1v[3]};
        const bf16x8 pa = __builtin_bit_cast(bf16x8, pw[s]);
        o0 = __builtin_amdgcn_mfma_f32_32x32x16_bf16(pa, v0, o0, 0, 0, 0);
        o1 = __builtin_amdgcn_mfma_f32_32x32x16_bf16(pa, v1, o1, 0, 0, 0);
    }
}
__device__ __forceinline__ float tile_finish(const f32x16& o0, const f32x16& o1, float m, float l, ALAS bfraw* stg, ALAS float* wsf, int r32, int hi) {
    asm volatile("" ::: "memory");
    const float lt = swapsum(l);
    const float rl = lt > 0.f ? 1.0f / lt : 0.f;
    if (hi == 0) wsf[32 + r32] = rl;
#pragma unroll
    for (int r = 0; r < 16; ++r) { const int q = crow(r, hi); const float a = wsf[32 + q];
        const unsigned w0 = cvtpk(o0[r] * a, 0.f), w1 = cvtpk(o1[r] * a, 0.f);
        stg[q * 64 + r32] = (bfraw)(w0 & 0xffffu); stg[q * 64 + 32 + r32] = (bfraw)(w1 & 0xffffu); }
    asm volatile("" ::: "memory");
    return m + __builtin_amdgcn_logf(lt);
}

__device__ __forceinline__ float attn_tile(const char* qb, unsigned qoff, const char* kb, const char* vb, unsigned kstrideB, int kidx0, int nch, int kmax, int qpos, int qlo, int qhi, float ns2,
                                           ALAS unsigned char* vimg, ALAS bfraw* stg, ALAS float* wsf, int lane) {
    const int r32 = lane & 31, hi = lane >> 5;
    bf16x8 qr[4];
#pragma unroll
    for (int d0 = 0; d0 < 4; ++d0) qr[d0] = *(const bf16x8*)(qb + (size_t)(qoff + 32u * d0 + 16u * hi));
    ALAS const unsigned char* vbl = vimg + ((lane >> 4) & 1) * 32 + (lane & 3) * 8 + (4 * hi + ((lane & 15) >> 2)) * 64;
    const int vkey = lane >> 3, vc16 = lane & 7;
    ALAS unsigned char* vw = vimg + (vc16 >> 2) * 2048 + (vc16 & 3) * 16;
    bf16x8 kf[4]; u32x4 vr[4];
#define ATT_LOADK(k0_) do { const unsigned oa_ = (unsigned)clampi((k0_) + r32, 0, kmax - 1) * kstrideB + 16u * hi; \
        _Pragma("unroll") for (int d0 = 0; d0 < 4; ++d0) kf[d0] = *(const bf16x8*)(kb + (size_t)(oa_ + 32u * d0)); } while (0)
#define ATT_LOADV(k0_) do { _Pragma("unroll") for (int i = 0; i < 4; ++i) { const unsigned ov_ = (unsigned)clampi((k0_) + 8 * i + vkey, 0, kmax - 1) * kstrideB + 16u * vc16; vr[i] = *(const u32x4*)(vb + (size_t)ov_); } } while (0)
    ATT_LOADK(kidx0); ATT_LOADV(kidx0);
    f32x16 o0, o1;
#pragma unroll
    for (int r = 0; r < 16; ++r) { o0[r] = 0.f; o1[r] = 0.f; }
    float m = -INFINITY, l = 0.f;
    for (int ch = 0; ch < nch; ++ch) {
        const int k0 = kidx0 + 32 * ch;
        const bool more = ch + 1 < nch;
        const float dqf = (float)(qpos - k0 - 4 * hi);
        f32x16 p0;
#pragma unroll
        for (int r = 0; r < 16; ++r) p0[r] = 0.f;
#pragma unroll
        for (int d0 = 0; d0 < 4; ++d0) p0 = __builtin_amdgcn_mfma_f32_32x32x16_bf16(kf[d0], qr[d0], p0, 0, 0, 0);
        if (more) ATT_LOADK(k0 + 32);
        asm volatile("" ::: "memory");
#pragma unroll
        for (int i = 0; i < 4; ++i) { const int key = 8 * i + vkey; *(ALAS u32x4*)(vw + (key >> 4) * 1024 + (key & 15) * 64) = vr[i]; }
        asm volatile("" ::: "memory");
        if (more) ATT_LOADV(k0 + 32);
        const bool band = (k0 + 31 > qlo || qhi - k0 > 128);
        chunk_softmax_pv(p0, dqf, ns2, band ? 2 : 0, k0 < 0, (float)(k0 + 4 * hi), vbl, o0, o1, m, l, wsf, r32, hi);
        asm volatile("" ::: "memory");
    }
#undef ATT_LOADK
#undef ATT_LOADV
    return tile_finish(o0, o1, m, l, stg, wsf, r32, hi);
}

__device__ __forceinline__ void coop_issue_stage(const char* kb, const char* vb, unsigned kstrideB, int key0, ALAS unsigned char* buf, int wave, int lane) {
    const char* src; unsigned off; int poff;
    if (wave < 4) { src = kb; off = (unsigned)(lane & 31) * kstrideB + (unsigned)(2 * wave + (lane >> 5)) * 16u; poff = wave * 1024; }
    else { const int p = wave - 4, dh = p >> 1, sg = p & 1; src = vb; off = (unsigned)(16 * sg + (lane >> 2)) * kstrideB + (unsigned)(4 * dh + (lane & 3)) * 16u; poff = 4096 + dh * 2048 + sg * 1024; }
    off += (unsigned)key0 * kstrideB;
#pragma unroll
    for (int j = 0; j < 4; ++j)
        __builtin_amdgcn_global_load_lds((const unsigned*)(src + (size_t)(off + (unsigned)(32 * j) * kstrideB)), (ALAS unsigned*)(buf + j * 8192 + poff), 16, 0, 0);
}
__device__ __forceinline__ void coop_compute_stage(ALAS const unsigned char* buf, int c0, int cuse, bool CAUSAL, const bf16x8 (&qr)[4], int qpos, float ns2,
                                                   f32x16& o0, f32x16& o1, float& m, float& l, ALAS float* wsf, int lane) {
    const int r32 = lane & 31, hi = lane >> 5;
    const int kl = hi * 512 + r32 * 16, vl = 4096 + ((lane >> 4) & 1) * 32 + (lane & 3) * 8 + (4 * hi + ((lane & 15) >> 2)) * 64;
#pragma unroll 1
    for (int j = 0; j < 4; ++j) {
        const int c = c0 + j;
        if (c < cuse) {
            ALAS const unsigned char* cb = buf + j * 8192;
            f32x16 p0;
#pragma unroll
            for (int r = 0; r < 16; ++r) p0[r] = 0.f;
#pragma unroll
            for (int d0 = 0; d0 < 4; ++d0) { const bf16x8 kf = *(ALAS const bf16x8*)(cb + d0 * 1024 + kl); p0 = __builtin_amdgcn_mfma_f32_32x32x16_bf16(kf, qr[d0], p0, 0, 0, 0); }
            const float dqf = (float)(qpos - 32 * c - 4 * hi);
            chunk_softmax_pv(p0, dqf, ns2, (CAUSAL && c == cuse - 1) ? 1 : 0, false, 0.f, cb + vl, o0, o1, m, l, wsf, r32, hi);
        }
    }
}
}

constexpr int NWAVES = 8;
constexpr int BATCH = 2, SEQ = 8192, D = 1024, FF = 2816, M = BATCH * SEQ;
constexpr int NQKV = 3840, NIN = 5888;
constexpr float QSCALE = 0.125f * 1.4426950408889634f;

constexpr size_t MiB = 1u << 20, KiB = 1u << 10;
constexpr size_t WS_CTL = 0, CTL_ZERO_BYTES = 1 * MiB;
constexpr size_t WS_W1C = 2 * MiB;
constexpr size_t WS_W1D = 13 * MiB;
constexpr size_t WS_WIN = WS_W1D + 5 * MiB + 512 * KiB;
constexpr size_t WS_WUA = 30 * MiB;
constexpr size_t WS_WUB = WS_WUA + 512 * KiB;
constexpr size_t WS_WO = WS_WUB + 1 * MiB;
constexpr size_t WS_W2C = WS_WO + 2 * MiB;
constexpr size_t WS_W2D = WS_W2C + 11 * MiB;
constexpr size_t WS_XB = 50 * MiB;
constexpr size_t WS_BIG = 82 * MiB;
constexpr size_t WS_H = WS_BIG;
constexpr size_t WS_QA = WS_BIG;
constexpr size_t WS_QB = WS_QA + 72 * MiB;
constexpr size_t WS_YA = 202 * MiB;
constexpr size_t WS_YB = 210 * MiB;
constexpr size_t WS_SCR = 226 * MiB;
constexpr size_t SCR_STRIDE = 104 * KiB, SCR_LSE = 96 * KiB;
constexpr size_t WS_GLIST = WS_W1C;
constexpr size_t WS_PARTO = WS_QA, WS_PARTL = WS_QA + 48 * MiB;
constexpr size_t WS_SIGA = WS_BIG, WS_SIGB = WS_BIG + 32 * MiB, WS_MG = WS_BIG + 64 * MiB;
constexpr size_t WS_END = 252 * MiB;
static_assert(WS_W2D + 5 * MiB + 512 * KiB <= WS_XB && WS_SCR + 256 * SCR_STRIDE <= WS_END && WS_PARTL + 2 * MiB <= WS_QB && WS_MG + 32 * MiB <= WS_YA, "d_ws map");
constexpr int CW_TMO = 0, CW_CODE = 1;
constexpr int CW_BAR = 4096;
constexpr int CW_QUEUE = 8192;
constexpr size_t CB_SSQ0 = 256 * KiB, CB_SSQ1 = 320 * KiB, CB_SSQ2 = 384 * KiB, CB_SSQ3 = 448 * KiB, CB_KSUM = 512 * KiB, CB_GCNT = 640 * KiB;

constexpr int RING_OFF = 0, RING_BYTES = 131072;
constexpr int LDSCTL_OFF = RING_BYTES, MISC_OFF = LDSCTL_OFF + 320;
constexpr int LDS_BYTES = 147456;
constexpr int AL_VIMG = 0, AL_STG = 65536, AL_WSF = 98304, AL_LIST = 100352, AL_CNT = 116736, AL_GPOS = 116864, AL_ITEM = 116992, AL_KS = 117760;
static_assert(AL_KS + 8192 <= RING_BYTES, "attention LDS map");

__device__ __forceinline__ float wave_sum(float v) {
#pragma unroll
    for (int o = 1; o < 64; o <<= 1) v += __shfl_xor(v, o);
    return v;
}
__device__ __forceinline__ void tr_item(const float* W, int K, int N, bf16* WT, int out_row0, int k0, int n0, const float* gain, float cs, LAS float* scr, int lane) {
    const int r = lane >> 4, c4 = lane & 15;
    f32x4 v[16];
#pragma unroll
    for (int i = 0; i < 16; ++i) v[i] = *(const GAS f32x4*)(W + (size_t)(k0 + 4 * i + r) * N + n0 + 4 * c4);
#pragma unroll
    for (int i = 0; i < 16; ++i) { const int k = 4 * i + r; const float g = gain ? gain[k0 + k] * cs : cs;
        *(LAS f32x4*)(scr + k * 64 + ((4 * c4) ^ (8 * ((k >> 3) & 7)))) = v[i] * g; }
    LDS_WAIT(); asm volatile("" ::: "memory");
    const int c = lane & 7;
#pragma unroll
    for (int j = 0; j < 8; ++j) { const int n = (lane >> 3) + 8 * j; const LAS float* s = scr + (8 * c) * 64 + (n ^ (8 * c));
        v4u o; o.x = pk2(s[0 * 64], s[1 * 64]); o.y = pk2(s[2 * 64], s[3 * 64]); o.z = pk2(s[4 * 64], s[5 * 64]); o.w = pk2(s[6 * 64], s[7 * 64]);
        *(GAS v4u*)(WT + (size_t)(out_row0 + n) * K + k0 + 8 * c) = o; }
    LDS_WAIT(); asm volatile("" ::: "memory");
}

struct Args { const float* in[15]; float* out; unsigned char* ws; };

struct Scr { bf16* O012; float* L012; };
__device__ __forceinline__ bf16* scr_o(const Scr& s, int slot, int q) { return s.O012 + ((size_t)slot * 256 + q) * 64; }
__device__ __forceinline__ float* scr_l(const Scr& s, int slot, int q) { return s.L012 + slot * 256 + q; }

__device__ __forceinline__ void merge_slots(const Scr& sc, unsigned mask, bf16* Y, int ldy, int tid) {
    asm volatile("" : "+v"(tid));
    const int q = tid >> 1, half = tid & 1;
    float L[4], mxl = -INFINITY;
#pragma unroll
    for (int s = 0; s < 4; ++s) { L[s] = -INFINITY; if (mask & (1u << s)) { L[s] = *scr_l(sc, s, q); mxl = fmaxf(mxl, L[s]); } }
    float acc[32];
#pragma unroll
    for (int i = 0; i < 32; ++i) acc[i] = 0.f;
    float den = 0.f;
#pragma unroll
    for (int s = 0; s < 4; ++s) if (mask & (1u << s)) {
        const float w = __builtin_amdgcn_exp2f(L[s] - mxl); den += w;
        const v4u* p = (const v4u*)(scr_o(sc, s, q) + half * 32);
#pragma unroll
        for (int i = 0; i < 4; ++i) { const v4u v = p[i];
            acc[8 * i + 0] += w * __uint_as_float(v.x << 16); acc[8 * i + 1] += w * __uint_as_float(v.x & 0xffff0000u);
            acc[8 * i + 2] += w * __uint_as_float(v.y << 16); acc[8 * i + 3] += w * __uint_as_float(v.y & 0xffff0000u);
            acc[8 * i + 4] += w * __uint_as_float(v.z << 16); acc[8 * i + 5] += w * __uint_as_float(v.z & 0xffff0000u);
            acc[8 * i + 6] += w * __uint_as_float(v.w << 16); acc[8 * i + 7] += w * __uint_as_float(v.w & 0xffff0000u); }
    }
    const float rd = 1.0f / den;
    v4u* o = (v4u*)(Y + (size_t)q * ldy + half * 32);
#pragma unroll
    for (int i = 0; i < 4; ++i) { v4u w; w.x = pk2(acc[8 * i] * rd, acc[8 * i + 1] * rd); w.y = pk2(acc[8 * i + 2] * rd, acc[8 * i + 3] * rd); w.z = pk2(acc[8 * i + 4] * rd, acc[8 * i + 5] * rd); w.w = pk2(acc[8 * i + 6] * rd, acc[8 * i + 7] * rd); o[i] = w; }
}

__device__ __forceinline__ void dsa_unit(int b, int j, int sp, unsigned char* ws, const Scr& sc, LAS unsigned char* lds, int tid) {
    asm volatile("" : "+v"(tid));
    const int lane = tid & 63, wave = __builtin_amdgcn_readfirstlane(tid >> 6), r32 = lane & 31, hi = lane >> 5;
    LAS unsigned char* vimg = lds + AL_VIMG + wave * 8192; LAS bf16* stg = (LAS bf16*)(lds + AL_STG + wave * 4096); LAS float* wsf = (LAS float*)(lds + AL_WSF + wave * 256);
    const int T0 = sp * 256;
    for (int T = wave; T < 32; T += NWAVES) {
        int g, dil, res, i0, nvalid = 32;
        if (T < 8) { g = 0; dil = 1; res = 0; i0 = T0 + 32 * T; }
        else if (T < 16) { g = 1; dil = 4; res = (T - 8) >> 1; i0 = (T0 >> 2) + 32 * (T & 1); }
        else { g = 2; dil = 16; res = T - 16; i0 = T0 >> 4; nvalid = 16; }
        const int h = 4 * g + j;
        const float ns2 = -__builtin_amdgcn_exp2f(-8.0f * (float)(h + 1) / 12.0f) * (float)dil * 1.4426950408889634f;
        const size_t base = (((size_t)b * SEQ + res) * 768 + (size_t)h * 64) * 2;
        const char* qb = (const char*)(ws + WS_QA) + base; const char* kb = qb + (size_t)M * 768 * 2; const char* vb = kb + (size_t)M * 768 * 2; const unsigned kstrideB = (unsigned)dil * 1536u;
        const int myrow = r32 & (nvalid - 1);
        int kidx0 = i0 + nvalid - 160, nch = 5;
        if (kidx0 < 0) { const int skip = (-kidx0) >> 5; kidx0 += 32 * skip; nch -= skip; }
        const float lse = att::attn_tile(qb, (unsigned)(i0 + myrow) * kstrideB, kb, vb, kstrideB, kidx0, nch, SEQ / dil, i0 + myrow, i0, i0 + nvalid - 1, ns2, vimg, stg, wsf, lane);
        const int qrow0 = i0 * dil + res - T0;
#pragma unroll
        for (int i = 0; i < 4; ++i) { const int row = i * 8 + (lane >> 3), chn = lane & 7; const v4u v = *(const LAS v4u*)(stg + row * 64 + chn * 8);
            if (row < nvalid) *(v4u*)(scr_o(sc, g, qrow0 + row * dil) + chn * 8) = v; }
        if (hi == 0 && r32 < nvalid) *scr_l(sc, g, qrow0 + r32 * dil) = lse;
        asm volatile("" ::: "memory");
    }
    asm volatile("s_waitcnt vmcnt(0)" ::: "memory");
    __syncthreads();
    merge_slots(sc, 7u, (bf16*)(ws + WS_YA) + ((size_t)b * SEQ + T0) * 256 + j * 64, 256, tid);
    asm volatile("s_waitcnt vmcnt(0)" ::: "memory");
    __syncthreads();
}

__device__ __forceinline__ void moba_gate_unit(int b, int h, int c, unsigned char* ws, LAS unsigned char* lds, int tid) {
    asm volatile("" : "+v"(tid));
    const int lane = tid & 63, wave = __builtin_amdgcn_readfirstlane(tid >> 6);
    LAS unsigned short* LIST = (LAS unsigned short*)(lds + AL_LIST); LAS int* CNT = (LAS int*)(lds + AL_CNT); LAS int* GPOS = (LAS int*)(lds + AL_GPOS); LAS float* KS = (LAS float*)(lds + AL_KS);
    const int nsel = c < 3 ? c : 3, bh = b * 8 + h;
    const char* QBb = (const char*)(ws + WS_QB) + ((size_t)b * SEQ * 512 + (size_t)h * 64) * 2;
    { const float* ks = (const float*)(ws + CB_KSUM) + ((size_t)bh * 32) * 64; for (int i = tid; i < c * 64; i += NWAVES * 64) KS[i] = ks[i]; }
    if (tid < 32) CNT[tid] = 0;
    __syncthreads();
    {
        const int q = tid >> 1, half = tid & 1;
        float qf[32];
        { const v4u* qp = (const v4u*)(QBb + ((size_t)(c * 256 + q) * 512 + half * 32) * 2);
#pragma unroll
          for (int i = 0; i < 4; ++i) { const v4u v = qp[i];
              qf[8 * i + 0] = __uint_as_float(v.x << 16); qf[8 * i + 1] = __uint_as_float(v.x & 0xffff0000u); qf[8 * i + 2] = __uint_as_float(v.y << 16); qf[8 * i + 3] = __uint_as_float(v.y & 0xffff0000u);
              qf[8 * i + 4] = __uint_as_float(v.z << 16); qf[8 * i + 5] = __uint_as_float(v.z & 0xffff0000u); qf[8 * i + 6] = __uint_as_float(v.w << 16); qf[8 * i + 7] = __uint_as_float(v.w & 0xffff0000u); } }
        float v1 = -INFINITY, v2 = -INFINITY, v3 = -INFINITY; int i1 = 0, i2 = 0, i3 = 0;
        for (int n = 0; n < c; ++n) {
            const LAS f32x4* kp = (const LAS f32x4*)(KS + n * 64 + half * 32);
            float dot = 0.f;
#pragma unroll
            for (int d4 = 0; d4 < 8; ++d4) { const f32x4 kv = kp[d4]; dot += qf[4 * d4] * kv[0] + qf[4 * d4 + 1] * kv[1] + qf[4 * d4 + 2] * kv[2] + qf[4 * d4 + 3] * kv[3]; }
            dot += __shfl_xor(dot, 1);
            if (dot > v1) { v3 = v2; i3 = i2; v2 = v1; i2 = i1; v1 = dot; i1 = n; }
            else if (dot > v2) { v3 = v2; i3 = i2; v2 = dot; i2 = n; }
            else if (dot > v3) { v3 = dot; i3 = n; }
        }
        if (half == 0) {
            const unsigned t = (unsigned)(c * 256 + q);
            { const int pos = atomicAdd((int*)(CNT + i1), 1); LIST[i1 * 256 + pos] = (unsigned short)(t | (0u << 13)); }
            if (nsel > 1) { const int pos = atomicAdd((int*)(CNT + i2), 1); LIST[i2 * 256 + pos] = (unsigned short)(t | (1u << 13)); }
            if (nsel > 2) { const int pos = atomicAdd((int*)(CNT + i3), 1); LIST[i3 * 256 + pos] = (unsigned short)(t | (2u << 13)); }
        }
    }
    __syncthreads();
    if (tid < c) { const int cn = CNT[tid]; GPOS[tid] = cn ? (int)__hip_atomic_fetch_add((unsigned*)(ws + CB_GCNT) + bh * 32 + tid, (unsigned)cn, __ATOMIC_RELAXED, __HIP_MEMORY_SCOPE_AGENT) : 0; }
    __syncthreads();
    unsigned short* GL = (unsigned short*)(ws + WS_GLIST) + (size_t)bh * 32 * 8192;
    for (int n = wave; n < c; n += NWAVES) { const int cn = CNT[n], g0 = GPOS[n];
        for (int i = lane; i < cn; i += 64) GL[(size_t)n * 8192 + g0 + i] = LIST[n * 256 + i]; }
    __syncthreads();
}

__device__ __forceinline__ void moba_stream_phase(const int which, unsigned char* ws, gu32* qctr, LAS unsigned char* lds, int tid) {
    asm volatile("" : "+v"(tid));
    const int lane = tid & 63, wave = __builtin_amdgcn_readfirstlane(tid >> 6), r32 = lane & 31, hi = lane >> 5;
    LAS bf16* stg = (LAS bf16*)(lds + AL_STG + wave * 4096); LAS float* wsf = (LAS float*)(lds + AL_WSF + wave * 256);
    LAS int* PREF = (LAS int*)(lds + AL_LIST); LAS int* LCNT = (LAS int*)(lds + AL_LIST + 2048); LAS int* NX = (LAS int*)(lds + AL_ITEM);
    const unsigned* GCNT = (const unsigned*)(ws + CB_GCNT);
    int nitems = 512;
    if (which == 0) {
        int g = 0; if (tid < 496) { const int cn = (int)GCNT[(tid & 15) * 32 + (tid >> 4)]; LCNT[tid] = cn; g = (cn + 255) >> 8; }
        int incl = g;
#pragma unroll
        for (int off = 1; off < 64; off <<= 1) { const int t = __shfl_up(incl, off); if (lane >= off) incl += t; }
        if (lane == 63) NX[8 + wave] = incl;
        __syncthreads();
        int add = 0;
        for (int w = 0; w < wave; ++w) add += NX[8 + w];
        PREF[tid] = incl + add;
        __syncthreads();
        nitems = PREF[495];
    }
#define MS_DECODE(T_) do { if (wave == 0) { int a_ = -1, b_ = 0; \
        if ((T_) < nitems) { if (which == 0) { int c_ = 0; _Pragma("unroll") for (int i_ = 0; i_ < 8; ++i_) c_ += (lane * 8 + i_ < 496 && PREF[lane * 8 + i_] <= (T_)) ? 1 : 0; \
                                              _Pragma("unroll") for (int o_ = 1; o_ < 64; o_ <<= 1) c_ += __shfl_xor(c_, o_); a_ = c_; b_ = (T_) - (c_ ? PREF[c_ - 1] : 0); } \
                           else { a_ = (T_) & 15; b_ = 31 - ((T_) >> 4); } } \
        if (lane == 0) { NX[0] = a_; NX[1] = b_; } } } while (0)
#define MS_KB(bh_, blk_) ((const char*)(ws + WS_QB) + (size_t)M * 512 * 2 + (((size_t)((bh_) >> 3) * SEQ + (size_t)(blk_) * 256) * 512 + (size_t)((bh_) & 7) * 64) * 2)
#define MS_ENT(a_, b_) ({ const int bh_ = (a_) & 15, n_ = (a_) >> 4; const int L_ = LCNT[(a_)]; int nv_ = L_ - 256 * (b_) - 32 * wave; nv_ = nv_ < 0 ? 0 : (nv_ > 32 ? 32 : nv_); \
        const int idx_ = 256 * (b_) + 32 * wave + (r32 < nv_ ? r32 : (nv_ ? nv_ - 1 : 0)); \
        nv_ ? (unsigned)((const unsigned short*)(ws + WS_GLIST))[((size_t)bh_ * 32 + n_) * 8192 + idx_] : 0u; })
    LAS unsigned char* const buf0 = lds + AL_VIMG; LAS unsigned char* const buf1 = lds + AL_VIMG + 32768;
    int Tq = 0; if (tid == 0) Tq = (int)__hip_atomic_fetch_add(qctr, 1u, RLX_AGENT);
    Tq = __builtin_amdgcn_readfirstlane(Tq);
    MS_DECODE(Tq);
    __syncthreads();
    int ia = NX[0], ib = NX[1];
    __syncthreads();
    if (ia < 0) return;
    { const int bh0 = which == 0 ? (ia & 15) : ia, blk0 = which == 0 ? (ia >> 4) : ib; const char* kb0 = MS_KB(bh0, blk0);
      att::coop_issue_stage(kb0, kb0 + (size_t)M * 512 * 2, 1024u, 0, buf0, wave, lane); }
    unsigned ent = 0; if (which == 0) ent = MS_ENT(ia, ib);
    for (;;) {
        const int bh = which == 0 ? (ia & 15) : ia, blk = which == 0 ? (ia >> 4) : ib;
        const int b = bh >> 3, h = bh & 7;
        const float ns2 = -__builtin_amdgcn_exp2f(-(float)(h + 1)) * 1.4426950408889634f;
        const char* kb = MS_KB(bh, blk); const char* vb = kb + (size_t)M * 512 * 2;
        const char* qbase = (const char*)(ws + WS_QB) + ((size_t)b * SEQ * 512 + (size_t)h * 64) * 2;
        int nvalid, cuse, qpos, tok;
        if (which == 0) { const int L = LCNT[ia]; nvalid = L - 256 * ib - 32 * wave; nvalid = nvalid < 0 ? 0 : (nvalid > 32 ? 32 : nvalid);
            tok = (int)(ent & 8191u); qpos = tok - 256 * blk; cuse = nvalid ? 8 : 0; }
        else { nvalid = 32; tok = 256 * blk + 32 * wave + r32; qpos = 32 * wave + r32; cuse = wave + 1; }
        att::bf16x8 qr[4];
#pragma unroll
        for (int d0 = 0; d0 < 4; ++d0) qr[d0] = *(const att::bf16x8*)(qbase + (size_t)((unsigned)tok * 1024u + 32u * d0 + 16u * hi));
        if (tid == 0) Tq = (int)__hip_atomic_fetch_add(qctr, 1u, RLX_AGENT);
        att::f32x16 o0, o1;
#pragma unroll
        for (int r = 0; r < 16; ++r) { o0[r] = 0.f; o1[r] = 0.f; }
        float m = -INFINITY, l = 0.f;
        __syncthreads();
        asm volatile("" :: "v"(qr[0]), "v"(qr[1]), "v"(qr[2]), "v"(qr[3]));
        Tq = __builtin_amdgcn_readfirstlane(Tq);
        MS_DECODE(Tq);
        att::coop_issue_stage(kb, vb, 1024u, 128, buf1, wave, lane);
        att::coop_compute_stage(buf0, 0, cuse, which == 1, qr, qpos, ns2, o0, o1, m, l, wsf, lane);
        __syncthreads();
        const int na = NX[0], nb = NX[1];
        unsigned nent = 0;
        if (na >= 0) { const int bh1 = which == 0 ? (na & 15) : na, blk1 = which == 0 ? (na >> 4) : nb; const char* kb1 = MS_KB(bh1, blk1);
            att::coop_issue_stage(kb1, kb1 + (size_t)M * 512 * 2, 1024u, 0, buf0, wave, lane);
            if (which == 0) nent = MS_ENT(na, nb); }
        att::coop_compute_stage(buf1, 4, cuse, which == 1, qr, qpos, ns2, o0, o1, m, l, wsf, lane);
        if (nvalid > 0) {
            const float lse = att::tile_finish(o0, o1, m, l, stg, wsf, r32, hi);
            if (which == 0) {
                bf16* PO = (bf16*)(ws + WS_PARTO); float* PL = (float*)(ws + WS_PARTL);
#pragma unroll
                for (int i = 0; i < 4; ++i) { const int row = i * 8 + (lane >> 3), chn = lane & 7; const v4u v = *(const LAS v4u*)(stg + row * 64 + chn * 8);
                    const unsigned e2 = (unsigned)__shfl((int)ent, row);
                    if (row < nvalid) *(v4u*)(PO + (((size_t)bh * 8192 + (e2 & 8191u)) * 3 + (e2 >> 13)) * 64 + chn * 8) = v; }
                if (hi == 0 && r32 < nvalid) PL[((size_t)bh * 8192 + (ent & 8191u)) * 3 + (ent >> 13)] = lse;
            } else {
                const bf16* PO = (const bf16*)(ws + WS_PARTO); const float* PL = (const float*)(ws + WS_PARTL);
                const int row = lane >> 1, half = lane & 1, nsel = blk < 3 ? blk : 3;
                const size_t t2 = (size_t)256 * blk + 32 * wave + row;
                float L[4]; L[3] = __shfl(lse, row); float mxl = L[3];
#pragma unroll
                for (int s = 0; s < 3; ++s) { L[s] = -INFINITY; if (s < nsel) { L[s] = PL[((size_t)bh * 8192 + t2) * 3 + s]; mxl = fmaxf(mxl, L[s]); } }
                float wgt[4], den = 0.f;
#pragma unroll
                for (int s = 0; s < 4; ++s) { wgt[s] = (s == 3 || s < nsel) ? __builtin_amdgcn_exp2f(L[s] - mxl) : 0.f; den += wgt[s]; }
                const float rd = 1.0f / den;
                bf16* yrow = (bf16*)(ws + WS_YB) + ((size_t)b * SEQ + t2) * 512 + h * 64 + half * 32;
#pragma unroll
                for (int qh = 0; qh < 2; ++qh) {
                    float acc[16];
#pragma unroll
                    for (int i = 0; i < 16; ++i) acc[i] = 0.f;
#pragma unroll
                    for (int s = 0; s < 4; ++s) if (s == 3 || s < nsel) {
                        const float w = wgt[s] * rd; v4u v[2];
                        if (s == 3) { v[0] = *(const LAS v4u*)(stg + row * 64 + half * 32 + qh * 16); v[1] = *(const LAS v4u*)(stg + row * 64 + half * 32 + qh * 16 + 8); }
                        else { const v4u* p = (const v4u*)(PO + (((size_t)bh * 8192 + t2) * 3 + s) * 64 + half * 32 + qh * 16); v[0] = p[0]; v[1] = p[1]; }
#pragma unroll
                        for (int i = 0; i < 2; ++i) {
                            acc[8 * i + 0] += w * __uint_as_float(v[i].x << 16); acc[8 * i + 1] += w * __uint_as_float(v[i].x & 0xffff0000u);
                            acc[8 * i + 2] += w * __uint_as_float(v[i].y << 16); acc[8 * i + 3] += w * __uint_as_float(v[i].y & 0xffff0000u);
                            acc[8 * i + 4] += w * __uint_as_float(v[i].z << 16); acc[8 * i + 5] += w * __uint_as_float(v[i].z & 0xffff0000u);
                            acc[8 * i + 6] += w * __uint_as_float(v[i].w << 16); acc[8 * i + 7] += w * __uint_as_float(v[i].w & 0xffff0000u); }
                    }
#pragma unroll
                    for (int i = 0; i < 2; ++i) { v4u w; w.x = pk2(acc[8 * i], acc[8 * i + 1]); w.y = pk2(acc[8 * i + 2], acc[8 * i + 3]); w.z = pk2(acc[8 * i + 4], acc[8 * i + 5]); w.w = pk2(acc[8 * i + 6], acc[8 * i + 7]);
                        *(v4u*)(yrow + qh * 16 + i * 8) = w; }
                }
            }
            asm volatile("" ::: "memory");
        }
        if (na < 0) break;
        ia = na; ib = nb; ent = nent;
    }
    __syncthreads();
#undef MS_DECODE
#undef MS_KB
#undef MS_ENT
}

#ifndef SKIP_MIXER
#define SKIP_MIXER 0
#endif
#ifndef SKIP_DSA
#define SKIP_DSA 0
#endif
#ifndef SKIP_MOBA
#define SKIP_MOBA 0
#endif
#ifndef P4_REPS
#define P4_REPS 1
#endif
#ifndef P4B_EXPM
#define P4B_EXPM 0
#endif
#ifndef P0_REPS
#define P0_REPS 1
#endif
#ifndef P1_REPS
#define P1_REPS 1
#endif
#ifndef P3_REPS
#define P3_REPS 1
#endif
#ifndef P5_REPS
#define P5_REPS 1
#endif
#define P_W1C ((bf16*)(ws + WS_W1C))
#define P_W1D ((bf16*)(ws + WS_W1D))
#define P_WIN ((bf16*)(ws + WS_WIN))
#define P_WUA ((bf16*)(ws + WS_WUA))
#define P_WUB ((bf16*)(ws + WS_WUB))
#define P_WO ((bf16*)(ws + WS_WO))
#define P_W2C ((bf16*)(ws + WS_W2C))
#define P_W2D ((bf16*)(ws + WS_W2D))
#define P_XB ((bf16*)(ws + WS_XB))
#define P_HB ((bf16*)(ws + WS_H))
#define P_QA ((bf16*)(ws + WS_QA))
#define P_QB ((bf16*)(ws + WS_QB))
#define P_YA ((bf16*)(ws + WS_YA))
#define P_YB ((bf16*)(ws + WS_YB))
#define P_SIGA ((bf16*)(ws + WS_SIGA))
#define P_SIGB ((bf16*)(ws + WS_SIGB))
#define P_MG ((bf16*)(ws + WS_MG))
#define P_SSQ0 ((float*)(ws + CB_SSQ0))
#define P_SSQ1 ((float*)(ws + CB_SSQ1))
#define P_SSQ2 ((float*)(ws + CB_SSQ2))
#define P_SSQ3 ((float*)(ws + CB_SSQ3))
#define P_KSUM ((float*)(ws + CB_KSUM))
__global__ void __launch_bounds__(NWAVES * 64, 2) fwd_megakernel(Args args) {
    extern __shared__ __attribute__((aligned(16))) unsigned char lds_raw[];
    LAS unsigned char* lds = (LAS unsigned char*)lds_raw;
    volatile LAS unsigned* MISC = (volatile LAS unsigned*)(lds + MISC_OFF);
    const int tid = threadIdx.x, lane = tid & 63, wave = __builtin_amdgcn_readfirstlane(tid >> 6);
    const int G = gridDim.x, bx = blockIdx.x;
    unsigned char* const ws = args.ws;
    const float* x_in = args.in[0];
    float* out = args.out;
    gu32* ctl = (gu32*)(ws + WS_CTL);
    for (int u = tid; u < (LDS_BYTES - LDSCTL_OFF) / 4; u += NWAVES * 64) ((LAS unsigned*)(lds + LDSCTL_OFF))[u] = 0u;
    __syncthreads();
    XcdBarrier bar = xcd_barrier_post((unsigned*)(ctl + CW_BAR), MISC + 8);
#define GRID_BAR() xcd_barrier(bar)

    for (int rep0 = 0; rep0 < P0_REPS; ++rep0) {
        if (rep0) GRID_BAR();
        LAS float* scr = (LAS float*)(lds + RING_OFF + wave * 16384);
        const int gw = bx * NWAVES + wave, NGW = G * NWAVES;
        constexpr int I_FU = (D / 64) * (FF / 64), I_FD = (FF / 64) * (D / 64), I_IN = (D / 64) * (NIN / 64), I_UA = (256 / 64) * (D / 64), I_UB = (512 / 64) * (D / 64), I_WO = (D / 64) * (D / 64);
        constexpr int NITEMS = 6 * I_FU + I_IN + I_UA + I_UB + I_WO;
        static_assert(I_FU == I_FD, "items");
        for (int it = gw; it < NITEMS; it += NGW) {
            int r = it;
            if (r < 4 * I_FU) { const int mat = r / I_FU; r -= mat * I_FU; const int nblk = FF / 64, kb = r / nblk, nb = r % nblk, n0 = 64 * nb;
                const float* W = mat == 0 ? args.in[2] : mat == 1 ? args.in[3] : mat == 2 ? args.in[11] : args.in[12]; const float* gain = mat < 2 ? args.in[1] : args.in[10];
                const int orow = 256 * (n0 >> 7) + (n0 & 127) + ((mat & 1) ? 128 : 0);
                tr_item(W, D, FF, mat < 2 ? P_W1C : P_W2C, orow, 64 * kb, n0, gain, 1.0f, scr, lane); continue; }
            r -= 4 * I_FU;
            if (r < 2 * I_FD) { const int mat = r / I_FD; r -= mat * I_FD; const int nblk = D / 64, kb = r / nblk, nb = r % nblk;
                tr_item(mat == 0 ? args.in[4] : args.in[13], FF, D, mat == 0 ? P_W1D : P_W2D, 64 * nb, 64 * kb, 64 * nb, nullptr, 1.0f, scr, lane); continue; }
            r -= 2 * I_FD;
            if (r < I_IN) { const int nblk = NIN / 64, kb = r / nblk, nb = r % nblk, n0 = 64 * nb; const bool isq = (n0 < 768) || (n0 >= 2304 && n0 < 2816);
                tr_item(args.in[6], D, NIN, P_WIN, n0, 64 * kb, n0, args.in[5], isq ? QSCALE : 1.0f, scr, lane); continue; }
            r -= I_IN;
            if (r < I_UA) { const int nblk = D / 64, kb = r / nblk, nb = r % nblk; tr_item(args.in[7], 256, D, P_WUA, 64 * nb, 64 * kb, 64 * nb, nullptr, 1.0f, scr, lane); continue; }
            r -= I_UA;
            if (r < I_UB) { const int nblk = D / 64, kb = r / nblk, nb = r % nblk; tr_item(args.in[8], 512, D, P_WUB, 64 * nb, 64 * kb, 64 * nb, nullptr, 1.0f, scr, lane); continue; }
            r -= I_UB;
            { const int nblk = D / 64, kb = r / nblk, nb = r % nblk; tr_item(args.in[9], D, D, P_WO, 64 * nb, 64 * kb, 64 * nb, nullptr, 1.0f, scr, lane); }
        }
        for (int m = 2 * gw; m < M; m += 2 * NGW) {
            const GAS f32x4* xr = (const GAS f32x4*)(x_in + (size_t)m * D) + lane; f32x4 v[8]; float s0 = 0.f, s1 = 0.f;
#pragma unroll
            for (int j = 0; j < 8; ++j) v[j] = xr[64 * j];
#pragma unroll
            for (int j = 0; j < 4; ++j) { s0 += (v[j].x * v[j].x + v[j].y * v[j].y) + (v[j].z * v[j].z + v[j].w * v[j].w); s1 += (v[4 + j].x * v[4 + j].x + v[4 + j].y * v[4 + j].y) + (v[4 + j].z * v[4 + j].z + v[4 + j].w * v[4 + j].w); }
            s0 = wave_sum(s0); s1 = wave_sum(s1);
            GAS unsigned long long* o8 = (GAS unsigned long long*)(P_XB + (size_t)m * D) + lane;
#pragma unroll
            for (int j = 0; j < 8; ++j) o8[64 * j] = (unsigned long long)pk2(v[j].x, v[j].y) | ((unsigned long long)pk2(v[j].z, v[j].w) << 32);
            if (lane == 0) { P_SSQ0[m] = s0; P_SSQ0[m + 1] = s1; }
        }
    }
    GRID_BAR();

    for (int rep1 = 0; rep1 < P1_REPS; ++rep1) {
        if (rep1) GRID_BAR();
        pg8::Gemm g{P_XB, P_W1C, M, 2 * FF, D}; pg8::StaticOrder S; S.init(M, 2 * FF, G, bx);
        pg8::EpiSwiGLU E{P_HB, FF, P_SSQ0};
        pg8::gemm_phase<pg8::EpiSwiGLU, pg8::StaticOrder, true, true>(lds + RING_OFF, g, S, E);
    }
    GRID_BAR();
    {
        pg8::Gemm g{P_HB, P_W1D, M, D, FF}; pg8::StaticOrder S; S.init(M, D, G, bx);
        pg8::EpiResid<true> E{args.in[0], args.out, P_XB, P_SSQ1, 0.5f, D};
        pg8::gemm_phase<pg8::EpiResid<true>, pg8::StaticOrder, true, true>(lds + RING_OFF, g, S, E);
    }
    GRID_BAR();
#if !SKIP_MIXER
    for (int rep3 = 0; rep3 < P3_REPS; ++rep3) {
        if (rep3) GRID_BAR();
        pg8::Gemm g{P_XB, P_WIN, M, NQKV, D}; pg8::StaticOrder S; S.init(M, NQKV, G, bx);
        pg8::EpiQKV E{P_QA, P_QB, P_SSQ1, P_KSUM, M};
        pg8::gemm_phase<pg8::EpiQKV, pg8::StaticOrder, true, true>(lds + RING_OFF, g, S, E);
    }
    GRID_BAR();
    {
        Scr sc; sc.O012 = (bf16*)(ws + WS_SCR + (size_t)bx * SCR_STRIDE); sc.L012 = (float*)(ws + WS_SCR + (size_t)bx * SCR_STRIDE + SCR_LSE);
        LAS int* ITEM = (LAS int*)(lds + AL_ITEM);
        int tid_a = threadIdx.x; asm volatile("" : "+v"(tid_a));
        for (;;) {
            if (tid == 0) ITEM[0] = (int)__hip_atomic_fetch_add(ctl + CW_QUEUE, 1u, RLX_AGENT);
            __syncthreads();
            const int it = ITEM[0];
            __syncthreads();
            if (it >= 256 + 496) break;
            if (it < 256) dsa_unit(it >> 7, (it >> 5) & 3, it & 31, ws, sc, lds, tid_a);
            else { const int g = it - 256; moba_gate_unit((g & 15) >> 3, g & 7, 31 - (g >> 4), ws, lds, tid_a); }
        }
    }
    GRID_BAR();
    moba_stream_phase(0, ws, ctl + CW_QUEUE + 64, lds, threadIdx.x);
    GRID_BAR();
    moba_stream_phase(1, ws, ctl + CW_QUEUE + 128, lds, threadIdx.x);
    GRID_BAR();
    for (int rep5 = 0; rep5 < P5_REPS; ++rep5) {
        if (rep5) GRID_BAR();
        pg8::StaticOrder S; S.init(M, D, G, bx);
        { pg8::Gemm g{P_XB, P_WIN + (size_t)NQKV * D, M, D, D}; pg8::EpiSig E{P_SIGA, D, P_SSQ1}; pg8::gemm_phase<pg8::EpiSig, pg8::StaticOrder, true, true>(lds + RING_OFF, g, S, E); }
        { pg8::Gemm g{P_XB, P_WIN + (size_t)(NQKV + D) * D, M, D, D}; pg8::EpiSig E{P_SIGB, D, P_SSQ1}; pg8::gemm_phase<pg8::EpiSig, pg8::StaticOrder, true, true>(lds + RING_OFF, g, S, E); }
        { pg8::Gemm g{P_YA, P_WUA, M, D, 256}; pg8::EpiGate<false> E{P_SIGA, P_MG, D}; pg8::gemm_phase<pg8::EpiGate<false>, pg8::StaticOrder, true, true>(lds + RING_OFF, g, S, E); }
        { pg8::Gemm g{P_YB, P_WUB, M, D, 512}; pg8::EpiGate<true> E{P_SIGB, P_MG, D}; pg8::gemm_phase<pg8::EpiGate<true>, pg8::StaticOrder, true, true>(lds + RING_OFF, g, S, E); }
    }
    GRID_BAR();
    {
        pg8::Gemm g{P_MG, P_WO, M, D, D}; pg8::StaticOrder S; S.init(M, D, G, bx);
        pg8::EpiResid<true> E{out, out, P_XB, P_SSQ2, 1.0f, D};
        pg8::gemm_phase<pg8::EpiResid<true>, pg8::StaticOrder, true, true>(lds + RING_OFF, g, S, E);
    }
    GRID_BAR();
    const float* SSQ_F2 = P_SSQ2;
#else
    const float* SSQ_F2 = P_SSQ1;
#endif
    {
        pg8::Gemm g{P_XB, P_W2C, M, 2 * FF, D}; pg8::StaticOrder S; S.init(M, 2 * FF, G, bx);
        pg8::EpiSwiGLU E{P_HB, FF, SSQ_F2};
        pg8::gemm_phase<pg8::EpiSwiGLU, pg8::StaticOrder, true, true>(lds + RING_OFF, g, S, E);
    }
    GRID_BAR();
    {
        pg8::Gemm g{P_HB, P_W2D, M, D, FF}; pg8::StaticOrder S; S.init(M, D, G, bx);
        pg8::EpiResid<false> E{out, out, nullptr, P_SSQ3, 0.5f, D};
        pg8::gemm_phase<pg8::EpiResid<false>, pg8::StaticOrder, true, true>(lds + RING_OFF, g, S, E);
    }
    GRID_BAR();
    {
        const int gw = bx * NWAVES + wave, NGW = G * NWAVES; const float* gf = args.in[14];
        const unsigned bad = __hip_atomic_load(ctl + CW_BAR + XB_TMO, RLX_AGENT);
        f32x4 gv[4];
#pragma unroll
        for (int j = 0; j < 4; ++j) gv[j] = ((const GAS f32x4*)gf)[lane + 64 * j];
        for (int m = gw; m < M; m += NGW) {
            GAS f32x4* xr = (GAS f32x4*)(out + (size_t)m * D) + lane; float r = __builtin_amdgcn_rsqf(P_SSQ3[m] * (1.0f / 1024.0f) + 1e-6f);
            if (bad) r = __builtin_nanf("");
#pragma unroll
            for (int j = 0; j < 4; ++j) { const f32x4 v = xr[64 * j]; xr[64 * j] = v * r * gv[j]; }
        }
    }
}

extern "C" void kernel_launch(void* const* d_in, const int* in_sizes, int n_in, void* d_out, int out_size, void* d_ws, size_t ws_size, hipStream_t stream) {
    static int grid = 0;
    if (grid == 0) {
        if (n_in != 15 || in_sizes[0] != M * D || out_size != M * D || ws_size < WS_END) { fprintf(stderr, "kernel_launch: unexpected shapes (n_in %d, in0 %d, out %d, ws %zu)\n", n_in, n_in > 0 ? in_sizes[0] : -1, out_size, ws_size); grid = -1; return; }
        int dev = 0, cus = 0, per_cu = 0;
        if (hipGetDevice(&dev) != hipSuccess || hipDeviceGetAttribute(&cus, hipDeviceAttributeMultiprocessorCount, dev) != hipSuccess) { grid = -1; return; }
        if (hipFuncSetAttribute((const void*)fwd_megakernel, hipFuncAttributeMaxDynamicSharedMemorySize, LDS_BYTES) != hipSuccess) { fprintf(stderr, "kernel_launch: hipFuncSetAttribute failed\n"); grid = -1; return; }
        if (hipOccupancyMaxActiveBlocksPerMultiprocessor(&per_cu, (const void*)fwd_megakernel, NWAVES * 64, LDS_BYTES) != hipSuccess || per_cu < 1)
            fprintf(stderr, "kernel_launch: note: occupancy query reports %d workgroups per CU\n", per_cu);
        (void)hipGetLastError();
        grid = cus > 256 ? 256 : cus;
    }
    if (grid < 0) return;
    if (hipMemsetAsync((char*)d_ws + WS_CTL, 0, CTL_ZERO_BYTES, stream) != hipSuccess) { fprintf(stderr, "kernel_launch: memset failed\n"); return; }
    Args a{};
    for (int i = 0; i < 15; ++i) a.in[i] = (const float*)d_in[i];
    a.out = (float*)d_out; a.ws = (unsigned char*)d_ws;
    hipLaunchKernelGGL(fwd_megakernel, dim3(grid), dim3(NWAVES * 64), LDS_BYTES, stream, a);
}
```
